# Optimizing an MI355X kernel written in HIP

```python
import math
import jax, jax.numpy as jnp
from jax import lax
import numpy as np

D_MODEL = 2048
BATCH = 4
SEQ = 4096
DEPTH = 2

N_MIXERS = 2
N_HEADS = 16
Q_LORA = 512
KV_LORA = 512
QK_NOPE = 128
QK_ROPE = 64
V_HEAD = 128
QK_HEAD = QK_NOPE + QK_ROPE
ROPE_THETA = 10000.0
Q_BLOCK = 128
POOL_WINDOWS = (2, 4, 8, 16)
N_POOL_GROUPS = len(POOL_WINDOWS)
POOL_GROUP = D_MODEL // N_POOL_GROUPS
D_FF = 4 * D_MODEL
EPS = 1e-6
N_ATTN_LAYERS = (DEPTH + 1) // 2
N_POOL_LAYERS = DEPTH // 2

kernel_name = "hybrid_mla_multiscale_pool_sqrelu"


def rmsnorm(x, g):
    x32 = x.astype(jnp.float32)
    y = x32 * lax.rsqrt(jnp.mean(x32 * x32, axis=-1, keepdims=True) + EPS)
    return (y * g.astype(jnp.float32)).astype(x.dtype)


def rope_tables(positions):
    inv_freq = 1.0 / (ROPE_THETA ** (jnp.arange(0, QK_ROPE, 2, dtype=jnp.float32) / QK_ROPE))
    ang = positions.astype(jnp.float32)[..., None] * inv_freq
    return jnp.cos(ang), jnp.sin(ang)


def apply_rope(x, cos, sin):
    x32 = x.astype(jnp.float32)
    x1, x2 = jnp.split(x32, 2, axis=-1)
    out = jnp.concatenate([x1 * cos - x2 * sin, x2 * cos + x1 * sin], axis=-1)
    return out.astype(x.dtype)


def latent_attention(x, positions, w_dqkv, q_norm, kv_norm, w_uq, w_ukv, w_o):
    B, S, _ = x.shape
    c = x @ w_dqkv
    c_q = rmsnorm(c[..., :Q_LORA], q_norm)
    c_kv = rmsnorm(c[..., Q_LORA:Q_LORA + KV_LORA], kv_norm)
    k_rope = c[..., Q_LORA + KV_LORA:][:, :, None, :]

    q = (c_q @ w_uq).reshape(B, S, N_HEADS, QK_HEAD)
    kv = (c_kv @ w_ukv).reshape(B, S, N_HEADS, QK_NOPE + V_HEAD)
    k_nope, v = kv[..., :QK_NOPE], kv[..., QK_NOPE:]

    cos, sin = rope_tables(positions)
    cos, sin = cos[:, :, None, :], sin[:, :, None, :]
    q = jnp.concatenate([q[..., :QK_NOPE], apply_rope(q[..., QK_NOPE:], cos, sin)], axis=-1)
    k_rope = apply_rope(k_rope, cos, sin)
    k = jnp.concatenate([k_nope, jnp.broadcast_to(k_rope, (B, S, N_HEADS, QK_ROPE))], axis=-1)

    scale = 1.0 / math.sqrt(QK_HEAD)
    n_blocks = S // Q_BLOCK
    q_blocks = q.reshape(B, n_blocks, Q_BLOCK, N_HEADS, QK_HEAD).transpose(1, 0, 2, 3, 4)
    key_pos = jnp.arange(S)

    def attend(args):
        qb, bi = args
        s = jnp.einsum('bqhd,bkhd->bhqk', qb, k).astype(jnp.float32) * scale
        q_pos = bi * Q_BLOCK + jnp.arange(Q_BLOCK)
        mask = key_pos[None, :] <= q_pos[:, None]
        s = jnp.where(mask[None, None], s, -jnp.inf)
        p = jax.nn.softmax(s, axis=-1).astype(v.dtype)
        return jnp.einsum('bhqk,bkhd->bqhd', p, v)

    o = lax.map(attend, (q_blocks, jnp.arange(n_blocks)))
    o = o.transpose(1, 0, 2, 3, 4).reshape(B, S, N_HEADS * V_HEAD)
    return o @ w_o


def multiscale_pool(x, w_pool, pool_scale):
    B, S, D = x.shape
    xg = x.astype(jnp.float32).reshape(B, S, N_POOL_GROUPS, POOL_GROUP)
    cs = jnp.cumsum(xg, axis=1)
    t = jnp.arange(S)
    pooled = []
    for g, w in enumerate(POOL_WINDOWS):
        csg = cs[:, :, g]
        prev = jnp.pad(csg, ((0, 0), (w, 0), (0, 0)))[:, :S]
        cnt = jnp.minimum(t + 1, w).astype(jnp.float32)[None, :, None]
        pooled.append((csg - prev) / cnt)
    y = (jnp.stack(pooled, axis=2) - xg).astype(x.dtype)
    y = jnp.einsum('bsgc,gcd->bsgd', y, w_pool).reshape(B, S, D)
    return y * pool_scale


def sqrelu_mlp(x, w_up, w_down):
    h = jax.nn.relu(x @ w_up)
    return (h * h) @ w_down


def setup_inputs(seed: int = 0) -> dict:
    key = jax.random.key(seed)
    ks = jax.random.split(key, 16)
    f32 = jnp.float32

    def nrm(k, shape, fan_in):
        return jax.random.normal(k, shape, f32) * (fan_in ** -0.5)

    def gain(k, shape):
        return 1.0 + 0.05 * jax.random.normal(k, shape, f32)

    na, nb, nl = N_ATTN_LAYERS, N_POOL_LAYERS, DEPTH
    return {
        "x": jax.random.normal(ks[0], (BATCH, SEQ, D_MODEL), f32),
        "positions": jnp.broadcast_to(jnp.arange(SEQ, dtype=jnp.int32), (BATCH, SEQ)),
        "ln_mix": gain(ks[1], (nl, D_MODEL)),
        "ln_mlp": gain(ks[2], (nl, D_MODEL)),
        "w_dqkv": nrm(ks[3], (na, D_MODEL, Q_LORA + KV_LORA + QK_ROPE), D_MODEL),
        "q_norm": gain(ks[4], (na, Q_LORA)),
        "kv_norm": gain(ks[5], (na, KV_LORA)),
        "w_uq": nrm(ks[6], (na, Q_LORA, N_HEADS * QK_HEAD), Q_LORA),
        "w_ukv": nrm(ks[7], (na, KV_LORA, N_HEADS * (QK_NOPE + V_HEAD)), KV_LORA),
        "w_o": nrm(ks[8], (na, N_HEADS * V_HEAD, D_MODEL), N_HEADS * V_HEAD),
        "w_pool": nrm(ks[9], (nb, N_POOL_GROUPS, POOL_GROUP, POOL_GROUP), POOL_GROUP),
        "pool_scale": gain(ks[10], (nb, D_MODEL)),
        "w_up": nrm(ks[11], (nl, D_MODEL, D_FF), D_MODEL),
        "w_down": nrm(ks[12], (nl, D_FF, D_MODEL), D_FF),
        "final_norm": gain(ks[13], (D_MODEL,)),
    }


def reference(x, positions, ln_mix, ln_mlp, w_dqkv, q_norm, kv_norm, w_uq, w_ukv, w_o,
              w_pool, pool_scale, w_up, w_down, final_norm):
    h = x
    for i in range(DEPTH):
        hn = rmsnorm(h, ln_mix[i])
        j = i // N_MIXERS
        if i % N_MIXERS == 0:
            mix = latent_attention(hn, positions, w_dqkv[j], q_norm[j], kv_norm[j],
                                   w_uq[j], w_ukv[j], w_o[j])
        else:
            mix = multiscale_pool(hn, w_pool[j], pool_scale[j])
        h = h + mix
        h = h + sqrelu_mlp(rmsnorm(h, ln_mlp[i]), w_up[i], w_down[i])
    return rmsnorm(h, final_norm)
```

```cpp
#include <hip/hip_runtime.h>
#include <hip/hip_cooperative_groups.h>
#include <hip/hip_bf16.h>
#include <cstdio>
#include <cstdint>
namespace cg = cooperative_groups;
#ifndef REP_P0
#define REP_P0 1
#endif
#ifndef REP_ATT
#define REP_ATT 1
#endif
#ifndef REP_UP
#define REP_UP 1
#endif

#define LAS __attribute__((address_space(3)))
typedef unsigned short bf16_t;
typedef short bf16x8 __attribute__((ext_vector_type(8)));
typedef short s16x4 __attribute__((ext_vector_type(4)));
typedef float f32x4 __attribute__((ext_vector_type(4)));
typedef float f32x16 __attribute__((ext_vector_type(16)));
typedef unsigned u32x4 __attribute__((ext_vector_type(4)));
typedef unsigned u32x2 __attribute__((ext_vector_type(2)));
typedef unsigned long long ssq_t;
__device__ __forceinline__ ssq_t ssq_fix(float s) { return (ssq_t)(s * 1048576.0f + 0.5f); }
__device__ __forceinline__ float ssq_f(ssq_t q) { return (float)q * (1.0f / 1048576.0f); }

constexpr int T = 16384, SEQ = 4096, DM = 2048, FF = 8192, NH = 16;
constexpr int NDQ = 1280;
constexpr int NQ = 3072, NKV = 4096;
constexpr float EPS = 1e-6f;

constexpr size_t MiB = 1u << 20;
constexpr size_t WS_CTL = 0;
constexpr size_t WS_WDQKV = 1 * MiB, WS_WUQ = 6 * MiB, WS_WUKV = 9 * MiB, WS_WO = 13 * MiB, WS_WPOOL = 21 * MiB, WS_WUP0 = 23 * MiB, WS_WDN0 = 55 * MiB;
constexpr size_t WS_ROPE = 87 * MiB, WS_XB = 91 * MiB;
constexpr size_t WS_Q = 155 * MiB, WS_KV = 251 * MiB, WS_CQKV = 379 * MiB, WS_O = 411 * MiB, WS_KR = 475 * MiB, WS_END = 477 * MiB;
constexpr size_t WS_H = 155 * MiB, WS_Y = 155 * MiB, WS_WUP1 = 411 * MiB, WS_WDN1 = 443 * MiB;
constexpr size_t WS_BAR = 960 * 1024, BAR_BYTES = 16384;
constexpr int SS_X = 0, SS_CQ = T, SS_CKV = 2 * T, SS_H1 = 3 * T, SS_H2 = 4 * T, SS_H3 = 5 * T, SS_H4 = 6 * T, SS_END = 7 * T;

__device__ __forceinline__ size_t xb_off(int row, int col) { return (((size_t)(row >> 8) * (DM / 64) + (col >> 6)) * 256 + (row & 255)) * 64 + (col & 63); }
__device__ __forceinline__ unsigned cvt_pk_bf16(float lo, float hi) { unsigned r; asm volatile("v_cvt_pk_bf16_f32 %0, %1, %2" : "=v"(r) : "v"(lo), "v"(hi)); return r; }

constexpr int STAT_LDS_OFF = 131072 + 1024;
namespace pg8 {
#define PG8_LAS __attribute__((address_space(3)))
constexpr int BM = 256, BK = 64, HALF = 128, HTB = HALF * BK * 2  , STAGE_BYTES = 8 * HTB, NXCD = 8, WGM = 4;

__host__ __device__ __forceinline__ int lds_byte(int r, int c) { const int st = (r >> 4) * 2 + (c >> 5), rr = r & 15, cc = c & 31, ob = rr * 64 + cc * 2; return st * 1024 + (ob ^ (((ob >> 9) & 1) << 5)); }
__host__ __device__ __forceinline__ void stage_rc(int b, int& R, int& C) { const int st = b / 1024, sb = b % 1024, swz = sb ^ (((sb >> 9) & 1) << 5); R = (st >> 1) * 16 + swz / 64; C = (st & 1) * 32 + (swz % 64) / 2; }
__host__ __device__ __forceinline__ int perm32(int rho) { const int n = rho >> 4, i = rho & 15; return 8 * (i >> 2) + 4 * n + (i & 3); }

struct Unit { int pm, pn; };
struct Gemm { const bf16_t* A; const bf16_t* Bt; int lda, ldb, K, grp; int ta = 0, tb = 0, apan = 0; };

struct StaticOrder {
    int nM, nN, nwg, G, c;
    __host__ __device__ void init(int M, int N, int G_, int c_) { nM = M / BM; nN = N / BM; nwg = nM * nN; G = G_; c = c_; }
    __host__ __device__ bool next(int i, Unit& u) const {
        const long L = (long)i * G + c; if (L >= nwg) return false;
        int wgid = (int)L; { const int q = nwg / NXCD, r = nwg % NXCD, xcd = wgid % NXCD, off = wgid / NXCD; wgid = (xcd < r ? xcd * (q + 1) : r * (q + 1) + (xcd - r) * q) + off; }
        const int nig = WGM * nN, gid = wgid / nig, fm = gid * WGM, gsz = (nM - fm) < WGM ? (nM - fm) : WGM;
        u.pm = fm + ((wgid % nig) % gsz); u.pn = (wgid % nig) / gsz; return true;
    }
};

template <class Epi, class Sched>
__device__ __forceinline__ void gemm_phase(PG8_LAS unsigned char* lds, const Gemm g, const Sched& S, const Epi& E) {
    int tid_ = threadIdx.x; asm volatile("" : "+v"(tid_));
    const int tid = tid_, wid = __builtin_amdgcn_readfirstlane(tid >> 6), lane = tid & 63, wr = wid >> 2, wc = wid & 3, fr = lane & 15, fq = lane >> 4;
    const int K = g.K, nt = K / BK;
    unsigned voffA[2], voffB[2];
#pragma unroll
    for (int i = 0; i < 2; ++i) { int R, C; stage_rc(tid * 16 + i * 8192, R, C); const int Rb = Epi::PERM ? ((R & ~31) + perm32(R & 31)) : R;
        voffA[i] = (unsigned)(R * (g.ta ? BK : g.lda) + C) * 2u; voffB[i] = (unsigned)(Rb * (g.tb ? BK : g.ldb) + C) * 2u; }
    const int rpa = g.ta ? BK : g.lda, rpb = g.tb ? BK : g.ldb;
    const size_t kstepA = g.ta ? (size_t)BM * BK * 2 : (size_t)(BK * 2), kstepB = g.tb ? (size_t)BM * BK * 2 : (size_t)(BK * 2);
    const size_t hstepA = (size_t)HALF * rpa * 2, hstepB = (size_t)HALF * rpb * 2;
    const size_t tstepA = g.ta ? (size_t)(g.apan ? g.apan : K / BK) * (BM * BK * 2) : 2 * hstepA, tstepB = g.tb ? (size_t)BM * K * 2 : 2 * hstepB;
    const unsigned ldsw = (unsigned)wid * 1024u;
    const int aoff = lds_byte(wr * 64 + fr, fq * 8), boff = lds_byte(wc * 32 + fr, fq * 8);
#define PG8_SA(b, h) (((b) * 2 + (h)) * HTB)
#define PG8_SB(b, h) ((4 + (b) * 2 + (h)) * HTB)
#define PG8_STAGE(bufoff, gbase, voff) do { _Pragma("unroll") for (int _i = 0; _i < 2; ++_i) \
        __builtin_amdgcn_global_load_lds((const unsigned*)((const char*)(gbase) + (voff)[_i]), (PG8_LAS unsigned*)(lds + (bufoff) + ldsw + _i * 8192), 16, 0, 0); } while (0)
#define PG8_LDA(dst, b, h) do { _Pragma("unroll") for (int m = 0; m < 4; ++m) _Pragma("unroll") for (int k = 0; k < 2; ++k) dst[m][k] = *(const PG8_LAS bf16x8*)(lds + PG8_SA(b, h) + aoff + m * 2048 + k * 1024); } while (0)
#define PG8_LDB(dst, b, h) do { _Pragma("unroll") for (int n = 0; n < 2; ++n) _Pragma("unroll") for (int k = 0; k < 2; ++k) dst[n][k] = *(const PG8_LAS bf16x8*)(lds + PG8_SB(b, h) + boff + n * 2048 + k * 1024); } while (0)
#define PG8_MMA(ai, bj, At, Bt) do { __builtin_amdgcn_s_setprio(1); _Pragma("unroll") for (int m = 0; m < 4; ++m) _Pragma("unroll") for (int n = 0; n < 2; ++n) _Pragma("unroll") for (int k = 0; k < 2; ++k) \
        acc[ai][bj][m][n] = __builtin_amdgcn_mfma_f32_16x16x32_bf16(Bt[n][k], At[m][k], acc[ai][bj][m][n], 0, 0, 0); __builtin_amdgcn_s_setprio(0); } while (0)
#define PG8_WAIT_V(n) asm volatile("s_waitcnt vmcnt(" #n ")" ::: "memory")
#define PG8_WAIT_L(n) asm volatile("s_waitcnt lgkmcnt(" #n ")" ::: "memory")
#define PG8_BAR __builtin_amdgcn_s_barrier()
#define PG8_SCHED __builtin_amdgcn_sched_barrier(0)
#define PG8_ABASE(u) ((const char*)g.A + (size_t)(u).pm * tstepA + (g.grp ? (size_t)((u).pn >> 1) * (g.ta ? (size_t)(K / BK) * (BM * BK * 2) : (size_t)K * 2) : (size_t)0))
    Unit cur, nxt; int ui = 0;
    if (!S.next(0, cur)) return;
    f32x4 acc[2][2][4][2];
#pragma unroll
    for (int a = 0; a < 2; ++a)
#pragma unroll
        for (int b = 0; b < 2; ++b)
#pragma unroll
            for (int m = 0; m < 4; ++m)
#pragma unroll
                for (int n = 0; n < 2; ++n) acc[a][b][m][n] = (f32x4){0.f, 0.f, 0.f, 0.f};
    bf16x8 At[4][2], B0[2][2], B1[2][2];
    const char* cA = PG8_ABASE(cur); const char* cB = (const char*)g.Bt + (size_t)cur.pn * tstepB;
    PG8_STAGE(PG8_SB(0, 0), cB, voffB); PG8_STAGE(PG8_SB(0, 1), cB + hstepB, voffB); PG8_STAGE(PG8_SA(0, 0), cA, voffA); PG8_STAGE(PG8_SA(0, 1), cA + hstepA, voffA);
    if (wr == 1) PG8_BAR;
    PG8_WAIT_V(2); PG8_BAR;
    PG8_STAGE(PG8_SB(1, 0), cB + kstepB, voffB); PG8_STAGE(PG8_SA(1, 0), cA + kstepA, voffA); PG8_STAGE(PG8_SB(1, 1), cB + hstepB + kstepB, voffB);
    PG8_WAIT_V(6); PG8_BAR;
    for (;;) {
        const bool has_next = S.next(ui + 1, nxt);
        const char* nA = has_next ? PG8_ABASE(nxt) : cA; const char* nB = has_next ? (const char*)g.Bt + (size_t)nxt.pn * tstepB : cB;
        for (int t = 0; t < nt; t += 2) {
            const bool last = (t == nt - 2);
            const char* a1 = cA + (size_t)(t + 1) * kstepA;
            const char* a2 = last ? nA : cA + (size_t)(t + 2) * kstepA; const char* b2 = last ? nB : cB + (size_t)(t + 2) * kstepB;
            const char* a3 = a2 + kstepA; const char* b3 = b2 + kstepB;
            if (Epi::NPRE && last) {
                const unsigned* src = (const unsigned*)(E.stat() + cur.pm * 256 + (wid & 3) * 64 + lane);
                __builtin_amdgcn_global_load_lds(src, (PG8_LAS unsigned*)(lds + STAT_LDS_OFF + (wid >> 2) * 2048 + (wid & 3) * 256), 4, 0, 0);
                __builtin_amdgcn_global_load_lds(src + 1, (PG8_LAS unsigned*)(lds + STAT_LDS_OFF + (wid >> 2) * 2048 + 1024 + (wid & 3) * 256), 4, 0, 0);
                PG8_SCHED; }
            PG8_LDB(B0, 0, 0); PG8_LDB(B1, 0, 1); PG8_SCHED; PG8_LDA(At, 0, 0); PG8_STAGE(PG8_SA(1, 1), a1 + hstepA, voffA);
            if (Epi::NPRE && last) PG8_WAIT_V(10); else PG8_WAIT_V(8);
            PG8_WAIT_L(0); PG8_BAR; PG8_MMA(0, 0, At, B0); PG8_MMA(0, 1, At, B1); PG8_BAR; PG8_SCHED;
            PG8_LDA(At, 0, 1); PG8_STAGE(PG8_SB(0, 0), b2, voffB); PG8_STAGE(PG8_SB(0, 1), b2 + hstepB, voffB); PG8_STAGE(PG8_SA(0, 0), a2, voffA);
            if (Epi::NPRE && last) PG8_WAIT_V(10); else PG8_WAIT_V(8);
            PG8_WAIT_L(0); PG8_BAR; PG8_MMA(1, 0, At, B0); PG8_MMA(1, 1, At, B1); PG8_BAR; PG8_SCHED;
            PG8_LDB(B0, 1, 0); PG8_LDB(B1, 1, 1); PG8_SCHED; PG8_LDA(At, 1, 0); PG8_STAGE(PG8_SA(0, 1), a2 + hstepA, voffA);
            PG8_WAIT_V(8); PG8_WAIT_L(0); PG8_BAR; PG8_MMA(0, 0, At, B0); PG8_MMA(0, 1, At, B1); PG8_BAR; PG8_SCHED;
            PG8_LDA(At, 1, 1); PG8_STAGE(PG8_SB(1, 0), b3, voffB); PG8_STAGE(PG8_SB(1, 1), b3 + hstepB, voffB); PG8_STAGE(PG8_SA(1, 0), a3, voffA);
            PG8_WAIT_V(8); PG8_WAIT_L(0); PG8_BAR; PG8_MMA(1, 0, At, B0); PG8_MMA(1, 1, At, B1); PG8_BAR; PG8_SCHED;
        }
        if (wr == 0) PG8_BAR;
        E(acc, cur, wr, wc, fr, fq, (const PG8_LAS unsigned*)(lds + STAT_LDS_OFF + wr * 2048));
        if (!has_next) break;
#pragma unroll
        for (int a = 0; a < 2; ++a)
#pragma unroll
            for (int b = 0; b < 2; ++b)
#pragma unroll
                for (int m = 0; m < 4; ++m)
#pragma unroll
                    for (int n = 0; n < 2; ++n) acc[a][b][m][n] = (f32x4){0.f, 0.f, 0.f, 0.f};
        cur = nxt; cA = nA; cB = nB; ++ui;
        if (wr == 1) PG8_BAR;
    }
    PG8_WAIT_V(0);
    PG8_BAR;
#undef PG8_ABASE
#undef PG8_SA
#undef PG8_SB
#undef PG8_STAGE
#undef PG8_LDA
#undef PG8_LDB
#undef PG8_MMA
#undef PG8_WAIT_V
#undef PG8_WAIT_L
#undef PG8_BAR
#undef PG8_SCHED
}
}

typedef const f32x4 (&AccRef)[2][2][4][2];
__device__ __forceinline__ float dot4(f32x4 v) { return (v[0] * v[0] + v[1] * v[1]) + (v[2] * v[2] + v[3] * v[3]); }
__device__ __forceinline__ u32x4 pack8v(f32x4 a, f32x4 b) { u32x4 w; w.x = cvt_pk_bf16(a[0], a[1]); w.y = cvt_pk_bf16(a[2], a[3]); w.z = cvt_pk_bf16(b[0], b[1]); w.w = cvt_pk_bf16(b[2], b[3]); return w; }
__device__ __forceinline__ void rope8(f32x4& v0, f32x4& v1, f32x4 cs, f32x4 sn) {
    f32x4 a, b;
    a[0] = v0[0] * cs[0] - v0[1] * sn[0]; a[1] = v0[1] * cs[0] + v0[0] * sn[0]; a[2] = v0[2] * cs[1] - v0[3] * sn[1]; a[3] = v0[3] * cs[1] + v0[2] * sn[1];
    b[0] = v1[0] * cs[2] - v1[1] * sn[2]; b[1] = v1[1] * cs[2] + v1[0] * sn[2]; b[2] = v1[2] * cs[3] - v1[3] * sn[3]; b[3] = v1[3] * cs[3] + v1[2] * sn[3];
    v0 = a; v1 = b;
}

struct EpiDqkv {
    static constexpr bool PERM = true;
    const ssq_t* ssx; ssq_t* sscq; ssq_t* ssckv; bf16_t* cqkv; bf16_t* kr; const float* rope;
    static constexpr int NPRE = 8;
    __device__ __forceinline__ const ssq_t* stat() const { return ssx; }
    __device__ __forceinline__ void operator()(AccRef acc, const pg8::Unit& u, int wr, int wc, int fr, int fq, const LAS unsigned* st) const {
        const int row0 = u.pm * 256 + wr * 64 + fr;
        if (u.pn < 4) {
            ssq_t* ssd = (u.pn < 2) ? sscq : ssckv;
            const int col0 = u.pn * 256 + wc * 32 + 8 * fq;
#pragma unroll
            for (int ai = 0; ai < 2; ++ai)
#pragma unroll
                for (int m = 0; m < 4; ++m) { const int row = row0 + ai * 128 + m * 16; const float rs = rsqrtf(ssq_f(((ssq_t)st[256 + ai * 128 + wr * 64 + m * 16 + fr] << 32) | st[ai * 128 + wr * 64 + m * 16 + fr]) * (1.f / DM) + EPS); float s = 0.f;
#pragma unroll
                    for (int bj = 0; bj < 2; ++bj) { const f32x4 v0 = acc[ai][bj][m][0] * rs, v1 = acc[ai][bj][m][1] * rs; s += dot4(v0) + dot4(v1);
                        *(u32x4*)(cqkv + ((((size_t)(row >> 8) * 16 + ((col0 + bj * 128) >> 6)) * 256 + (row & 255)) * 64 + ((col0 + bj * 128) & 63))) = pack8v(v0, v1); }
                    s += __shfl_xor(s, 16); s += __shfl_xor(s, 32);
                    if (fq == 0) atomicAdd(ssd + row, ssq_fix(s)); }
        } else if (wc < 2) {
            const int cc = wc * 32 + 8 * fq, j0 = cc >> 1;
#pragma unroll
            for (int ai = 0; ai < 2; ++ai)
#pragma unroll
                for (int m = 0; m < 4; ++m) { const int row = row0 + ai * 128 + m * 16; const float rs = rsqrtf(ssq_f(((ssq_t)st[256 + ai * 128 + wr * 64 + m * 16 + fr] << 32) | st[ai * 128 + wr * 64 + m * 16 + fr]) * (1.f / DM) + EPS);
                    f32x4 v0 = acc[ai][0][m][0] * rs, v1 = acc[ai][0][m][1] * rs;
                    const f32x4 cs = *(const f32x4*)(rope + (size_t)row * 64 + j0), sn = *(const f32x4*)(rope + (size_t)row * 64 + 32 + j0);
                    rope8(v0, v1, cs, sn);
                    *(u32x4*)(kr + (size_t)row * 64 + cc) = pack8v(v0, v1); }
        }
    }
};
struct EpiUq {
    static constexpr bool PERM = true;
    const ssq_t* ss; bf16_t* q; const float* rope;
    static constexpr int NPRE = 8;
    __device__ __forceinline__ const ssq_t* stat() const { return ss; }
    __device__ __forceinline__ void operator()(AccRef acc, const pg8::Unit& u, int wr, int wc, int fr, int fq, const LAS unsigned* st) const {
        const int row0 = u.pm * 256 + wr * 64 + fr;
#pragma unroll
        for (int bj = 0; bj < 2; ++bj) {
            const int col = u.pn * 256 + bj * 128 + wc * 32 + 8 * fq; const int h = col / 192, wi = col - h * 192; const bool rot = wi >= 128; const int j0 = (wi - 128) >> 1;
#pragma unroll
            for (int ai = 0; ai < 2; ++ai)
#pragma unroll
                for (int m = 0; m < 4; ++m) { const int row = row0 + ai * 128 + m * 16; const float rs = rsqrtf(ssq_f(((ssq_t)st[256 + ai * 128 + wr * 64 + m * 16 + fr] << 32) | st[ai * 128 + wr * 64 + m * 16 + fr]) * (1.f / 512.f) + EPS);
                    f32x4 v0 = acc[ai][bj][m][0] * rs, v1 = acc[ai][bj][m][1] * rs;
                    if (rot) { const f32x4 cs = *(const f32x4*)(rope + (size_t)row * 64 + j0), sn = *(const f32x4*)(rope + (size_t)row * 64 + 32 + j0); rope8(v0, v1, cs, sn); }
                    *(u32x4*)(q + ((size_t)((row >> 12) * NH + h) * SEQ + (row & (SEQ - 1))) * 192 + wi) = pack8v(v0, v1); }
        }
    }
};
template <int ACT> struct EpiScale {
    static constexpr bool PERM = true;
    const ssq_t* ss; float invk; bf16_t* o; int ldc;
    static constexpr int NPRE = 8;
    __device__ __forceinline__ const ssq_t* stat() const { return ss; }
    __device__ __forceinline__ void operator()(AccRef acc, const pg8::Unit& u, int wr, int wc, int fr, int fq, const LAS unsigned* st) const {
        const int row0 = u.pm * 256 + wr * 64 + fr, col0 = u.pn * 256 + wc * 32 + 8 * fq;
#pragma unroll
        for (int ai = 0; ai < 2; ++ai)
#pragma unroll
            for (int m = 0; m < 4; ++m) { const int row = row0 + ai * 128 + m * 16; const float rs = rsqrtf(ssq_f(((ssq_t)st[256 + ai * 128 + wr * 64 + m * 16 + fr] << 32) | st[ai * 128 + wr * 64 + m * 16 + fr]) * invk + EPS);
#pragma unroll
                for (int bj = 0; bj < 2; ++bj) { f32x4 v0 = acc[ai][bj][m][0] * rs, v1 = acc[ai][bj][m][1] * rs;
                    if (ACT == 1) {
                        const float INF = __builtin_inff();
#pragma unroll
                        for (int e = 0; e < 4; ++e) { v0[e] = __builtin_amdgcn_fmed3f(v0[e], 0.f, INF); v1[e] = __builtin_amdgcn_fmed3f(v1[e], 0.f, INF); }
                        v0 = v0 * v0; v1 = v1 * v1; }
                    if (ACT == 1) { const int cl = wc * 32 + 8 * fq + bj * 128;
                        *(u32x4*)(o + (((size_t)u.pm * (ldc >> 6) + u.pn * 4 + (cl >> 6)) * 256 + (row - u.pm * 256)) * 64 + (cl & 63)) = pack8v(v0, v1); }
                    else *(u32x4*)(o + (size_t)row * ldc + col0 + bj * 128) = pack8v(v0, v1); } }
    }
};
__device__ __forceinline__ f32x4 unpk_lo(u32x4 w) { f32x4 r; r[0] = __uint_as_float(w.x << 16); r[1] = __uint_as_float(w.x & 0xffff0000u); r[2] = __uint_as_float(w.y << 16); r[3] = __uint_as_float(w.y & 0xffff0000u); return r; }
__device__ __forceinline__ f32x4 unpk_hi(u32x4 w) { f32x4 r; r[0] = __uint_as_float(w.z << 16); r[1] = __uint_as_float(w.z & 0xffff0000u); r[2] = __uint_as_float(w.w << 16); r[3] = __uint_as_float(w.w & 0xffff0000u); return r; }
template <bool BF32, bool OF32> struct EpiRes2 {
    static constexpr bool PERM = true; static constexpr int NPRE = 0;
    const void* base; void* out; ssq_t* ss;
    __device__ __forceinline__ const ssq_t* stat() const { return nullptr; }
    __device__ __forceinline__ void operator()(AccRef acc, const pg8::Unit& u, int wr, int wc, int fr, int fq, const LAS unsigned*) const {
        const int row0 = u.pm * 256 + wr * 64 + fr, col0 = u.pn * 256 + wc * 32 + 8 * fq;
#pragma unroll
        for (int ai = 0; ai < 2; ++ai)
#pragma unroll
            for (int m = 0; m < 4; ++m) { const int row = row0 + ai * 128 + m * 16; float s = 0.f;
#pragma unroll
                for (int bj = 0; bj < 2; ++bj) { const size_t off = (BF32 || OF32) ? (size_t)row * DM + col0 + bj * 128 : xb_off(row, col0 + bj * 128); f32x4 b0, b1;
                    if (BF32) { b0 = *(const f32x4*)((const float*)base + off); b1 = *(const f32x4*)((const float*)base + off + 4); }
                    else { const u32x4 w = *(const u32x4*)((const bf16_t*)base + off); b0 = unpk_lo(w); b1 = unpk_hi(w); }
                    f32x4 o0 = b0 + acc[ai][bj][m][0], o1 = b1 + acc[ai][bj][m][1];
                    if (OF32) { *(f32x4*)((float*)out + off) = o0; *(f32x4*)((float*)out + off + 4) = o1; }
                    else { const u32x4 w = pack8v(o0, o1); *(u32x4*)((bf16_t*)out + off) = w; o0 = unpk_lo(w); o1 = unpk_hi(w); }
                    s += dot4(o0) + dot4(o1); }
                s += __shfl_xor(s, 16); s += __shfl_xor(s, 32);
                if (fq == 0) atomicAdd(ss + row, ssq_fix(s));
                asm volatile("" ::: "memory"); }
    }
};
namespace att {
constexpr int NW = 8, QBLK = 32, KVBLK = 64, QB = NW * QBLK;
constexpr int QS = 192, KVS = NKV, KRS = 64, OS = DM;
constexpr int KROW = 384;
constexpr int SHM_V = KVBLK * 128 * 2, SHM_K = KVBLK * KROW;
constexpr int QR_OFF = 2 * SHM_V + 2 * SHM_K + NW * 64 * 4;
constexpr int LDS_BYTES = QR_OFF + NW * 4096;
constexpr float SCALE = 0.07216878364870322f;
constexpr float THR = 8.f;
constexpr int W = SEQ;
#define KSWZ(row, colB) ((row) * 384 + ((colB) ^ (((row) & 7) << 4)))
#define SBAR() __builtin_amdgcn_sched_barrier(0)
__device__ __forceinline__ int v_st(int k, int c) { const int kk = (k & ~0xC) | ((k & 4) << 1) | ((k & 8) >> 1); return ((kk >> 3) * 4 + (c >> 5)) * 512 + ((kk & 7) * 32 + (c & 31)) * 2; }
__device__ __forceinline__ int v_rd_base(int lane) { return ((lane & 3) << 3) | (((lane >> 2) & 3) << 6) | (((lane >> 4) & 1) << 5) | (((lane >> 5) & 1) << 8); }
constexpr int v_rd_off(int d0, int ks, int half) { return d0 * 512 + ks * 4096 + half * 2048; }
__device__ __forceinline__ int crow(int r, int hi) { return (r & 3) + 8 * (r >> 2) + 4 * hi; }
__device__ __forceinline__ bf16x8 load8(const bf16_t* p) { return *reinterpret_cast<const bf16x8*>(p); }
__device__ __forceinline__ void mask_tile(f32x16& p0, f32x16& p1, int dq, unsigned Wn) {
    const float NEG = -__builtin_inff();
#pragma unroll
    for (int r = 0; r < 16; ++r) {
        const int c = (r & 3) + 8 * (r >> 2);
        if ((unsigned)(dq - c) >= Wn) p0[r] = NEG;
        if ((unsigned)(dq - c - 32) >= Wn) p1[r] = NEG;
    }
}
__device__ __forceinline__ void partialSM(f32x16& p0, f32x16& p1, float& m_reg, float& mn, float& alpha) {
    float pmax = p0[0];
#pragma unroll
    for (int r = 1; r < 16; ++r) pmax = fmaxf(pmax, p0[r]);
#pragma unroll
    for (int r = 0; r < 16; ++r) pmax = fmaxf(pmax, p1[r]);
    { auto rr = __builtin_amdgcn_permlane32_swap(__float_as_uint(pmax), __float_as_uint(pmax), false, false);
      pmax = fmaxf(__uint_as_float(rr[0]), __uint_as_float(rr[1])); }
    constexpr float C2 = 1.4426950408889634f * SCALE;
    if (__builtin_expect(__all((pmax - m_reg) * SCALE <= THR), 1)) { mn = m_reg; alpha = 1.f; }
    else { mn = fmaxf(m_reg, pmax); alpha = __builtin_amdgcn_exp2f((m_reg - mn) * C2); m_reg = mn; }
    const float mnL = -mn * C2;
#pragma unroll
    for (int r = 0; r < 16; ++r) p0[r] = fmaf(p0[r], C2, mnL);
#pragma unroll
    for (int r = 0; r < 16; ++r) p1[r] = fmaf(p1[r], C2, mnL);
#pragma unroll
    for (int r = 0; r < 16; ++r) p0[r] = __builtin_amdgcn_exp2f(p0[r]);
}
__device__ __forceinline__ void finishSM(f32x16& p0, f32x16& p1, float alpha, float& l_reg, bf16x8& pa0, bf16x8& pa1, bf16x8& pa2, bf16x8& pa3) {
#pragma unroll
    for (int r = 0; r < 16; ++r) p1[r] = __builtin_amdgcn_exp2f(p1[r]);
    float ps = 0;
#pragma unroll
    for (int r = 0; r < 16; ++r) ps += p0[r];
#pragma unroll
    for (int r = 0; r < 16; ++r) ps += p1[r];
    { auto rr = __builtin_amdgcn_permlane32_swap(__float_as_uint(ps), __float_as_uint(ps), false, false);
      ps = __uint_as_float(rr[0]) + __uint_as_float(rr[1]); }
    l_reg = l_reg * alpha + ps;
#define PK4(P, B_, OUT) do { unsigned a0 = cvt_pk_bf16(P[B_+0], P[B_+1]), a1 = cvt_pk_bf16(P[B_+2], P[B_+3]);                          \
        unsigned b0 = cvt_pk_bf16(P[B_+4], P[B_+5]), b1 = cvt_pk_bf16(P[B_+6], P[B_+7]);                                             \
        auto r0 = __builtin_amdgcn_permlane32_swap(a0, b0, false, false); auto r1 = __builtin_amdgcn_permlane32_swap(a1, b1, false, false); \
        u32x4 w = {r0[0], r1[0], r0[1], r1[1]}; OUT = *reinterpret_cast<bf16x8*>(&w); } while (0)
    PK4(p0, 0, pa0); PK4(p0, 8, pa1); PK4(p1, 0, pa2); PK4(p1, 8, pa3);
#undef PK4
}
template <int KB>
__device__ __forceinline__ void qkt(f32x16& p0, f32x16& p1, const char* K_lds, int r32, int hi, const bf16x8* qr, const LAS char* qrp) {
    p0 = f32x16{}; p1 = f32x16{};
    asm volatile("" : "+v"(qrp));
    const char* kb[4];
#pragma unroll
    for (int dd = 0; dd < 4; ++dd) kb[dd] = K_lds + KB * SHM_K + KSWZ(r32, (dd * 16 + hi * 8) * 2);
#pragma unroll
    for (int d0 = 0; d0 < 12; ++d0) { const char* a = kb[d0 & 3] + (d0 >> 2) * 128;
        bf16x8 b0 = *reinterpret_cast<const bf16x8*>(a);
        bf16x8 b1 = *reinterpret_cast<const bf16x8*>(a + 32 * KROW);
        const bf16x8 qv = d0 < 8 ? qr[d0 & 7] : *reinterpret_cast<const LAS bf16x8*>(qrp + (d0 - 8) * 1024);
        p0 = __builtin_amdgcn_mfma_f32_32x32x16_bf16(b0, qv, p0, 0, 0, 0);
        p1 = __builtin_amdgcn_mfma_f32_32x32x16_bf16(b1, qv, p1, 0, 0, 0); }
}
template <int VB>
__device__ __forceinline__ void pv_tile(f32x16* o, int vb0, bf16x8 pa0, bf16x8 pa1, bf16x8 pa2, bf16x8 pa3) {
#define TRRD(dst, off) asm volatile("ds_read_b64_tr_b16 %0, %1 offset:%2" : "=&v"(dst) : "v"(vb0), "i"(off) : "memory")
#define PV_D0(d0) do { s16x4 l0, l1, l2, l3, h0, h1, h2, h3; constexpr int b_ = VB * SHM_V + v_rd_off(d0, 0, 0); \
        TRRD(l0, b_); TRRD(h0, b_ + 2048); TRRD(l1, b_ + 4096); TRRD(h1, b_ + 6144); TRRD(l2, b_ + 8192); TRRD(h2, b_ + 10240); TRRD(l3, b_ + 12288); TRRD(h3, b_ + 14336); \
        asm volatile("s_waitcnt lgkmcnt(0)" ::: "memory"); SBAR();   \
        o[d0] = __builtin_amdgcn_mfma_f32_32x32x16_bf16(pa0, (bf16x8){l0[0], l0[1], l0[2], l0[3], h0[0], h0[1], h0[2], h0[3]}, o[d0], 0, 0, 0);   \
        o[d0] = __builtin_amdgcn_mfma_f32_32x32x16_bf16(pa1, (bf16x8){l1[0], l1[1], l1[2], l1[3], h1[0], h1[1], h1[2], h1[3]}, o[d0], 0, 0, 0);   \
        o[d0] = __builtin_amdgcn_mfma_f32_32x32x16_bf16(pa2, (bf16x8){l2[0], l2[1], l2[2], l2[3], h2[0], h2[1], h2[2], h2[3]}, o[d0], 0, 0, 0);   \
        o[d0] = __builtin_amdgcn_mfma_f32_32x32x16_bf16(pa3, (bf16x8){l3[0], l3[1], l3[2], l3[3], h3[0], h3[1], h3[2], h3[3]}, o[d0], 0, 0, 0); } while (0)
    PV_D0(0); PV_D0(1); PV_D0(2); PV_D0(3);
#undef PV_D0
#undef TRRD
}

struct BlockRef { const bf16_t* Q; const bf16_t* K; const bf16_t* V; const bf16_t* R; bf16_t* O; int P0; };
struct Seam { bf16x8 qr[8]; bf16x8 st_0, st_1, st_r; };
#define VMW() asm volatile("s_waitcnt vmcnt(0)" ::: "memory")
#define VMWN(n) asm volatile("s_waitcnt vmcnt(%0)" :: "i"(n) : "memory")
#define SLOAD_K(B_, k0) do { const char* kb_ = (const char*)(B_).K + (size_t)(k0) * (KVS * 2); const char* kb2_ = kb_ + 32 * KVS * 2; const char* rb_ = (const char*)(B_).R + (size_t)(k0) * (KRS * 2);   \
                             S.st_0 = *(const bf16x8*)(kb_ + glo); S.st_1 = *(const bf16x8*)(kb2_ + glo); S.st_r = *(const bf16x8*)(rb_ + gro); } while (0)
#define SLOAD_V(B_, k0) do { const char* kb_ = (const char*)(B_).K + (size_t)(k0) * (KVS * 2); const char* kb2_ = kb_ + 32 * KVS * 2;   \
                             S.st_0 = *(const bf16x8*)(kb_ + 256 + glo); S.st_1 = *(const bf16x8*)(kb2_ + 256 + glo); } while (0)
#define SWRITE_K(bf) do { *(bf16x8*)(K_lds + (bf) * SHM_K + kws) = S.st_0; *(bf16x8*)(K_lds + (bf) * SHM_K + kws + 32 * KROW) = S.st_1; *(bf16x8*)(K_lds + (bf) * SHM_K + krs) = S.st_r; } while (0)
#define SWRITE_V(bf) do { *(bf16x8*)(V_lds + (bf) * SHM_V + vst0) = S.st_0; *(bf16x8*)(V_lds + (bf) * SHM_V + vst0 + 8192) = S.st_1; } while (0)
#define QLOAD(B_) do { const char* qb_ = (const char*)(B_).Q + (size_t)(wid * QBLK) * (QS * 2); const unsigned qo_ = (unsigned)(r32 * QS + hi * 8) * 2u; _Pragma("unroll") for (int d0 = 0; d0 < 8; ++d0) S.qr[d0] = *(const bf16x8*)(qb_ + d0 * 32 + qo_); } while (0)
#define QRLOAD(B_) do { bf16x8 qt_[4]; _Pragma("unroll") for (int d0 = 0; d0 < 4; ++d0) qt_[d0] = *(const bf16x8*)((const char*)(B_).Q + (size_t)(wid * QBLK) * (QS * 2) + 256 + d0 * 32 + (unsigned)(r32 * QS + hi * 8) * 2u); VMW(); \
                        _Pragma("unroll") for (int d0 = 0; d0 < 4; ++d0) *(LAS bf16x8*)(qrp + d0 * 1024) = qt_[d0]; asm volatile("s_waitcnt lgkmcnt(0)" ::: "memory"); } while (0)
#define QRP_DECL LAS char* qrp = (LAS char*)lds + QR_OFF + wid * 4096 + lane * 16

__device__ __forceinline__ void prime(const BlockRef& cur, char* lds, Seam& S) {
    const int tid = threadIdx.x, wid = __builtin_amdgcn_readfirstlane(tid >> 6), lane = tid & 63, r32 = lane & 31, hi = lane >> 5;
    const int sr = tid >> 4, sc = (tid & 15) * 8, kws = KSWZ(sr, sc * 2), rr = tid >> 3, rc = (tid & 7) * 8, krs = KSWZ(rr, 256 + rc * 2); char* K_lds = lds + 2 * SHM_V;
    const unsigned glo = (unsigned)(sr * KVS + sc) * 2u, gro = (unsigned)(rr * KRS + rc) * 2u;
    QRP_DECL;
    QLOAD(cur);
    SLOAD_K(cur, 0); VMW(); SWRITE_K(0); SBAR();
    QRLOAD(cur);
    SLOAD_V(cur, 0);
    __syncthreads();
}
__device__ __forceinline__ void block(const BlockRef& cur, const BlockRef& nxt, char* lds, Seam& S) {
    const int tid = threadIdx.x, wid = __builtin_amdgcn_readfirstlane(tid >> 6), lane = tid & 63, r32 = lane & 31, hi = lane >> 5;
    const int NT = (cur.P0 + QB - 1) / KVBLK + 1;
    const int qlo = cur.P0 + wid * QBLK, qm = qlo + r32 - 4 * hi;
    char* V_lds = lds; char* K_lds = lds + 2 * SHM_V;
    float* ws = (float*)(lds + 2 * SHM_V + 2 * SHM_K) + wid * 64; float* li_l = ws, * al_l = ws + 32;
    float m_reg = -1e30f, l_reg = 0; f32x16 o[4] = {};
    const int sr = tid >> 4, sc = (tid & 15) * 8, vst0 = v_st(sr, sc), kws = KSWZ(sr, sc * 2), rr = tid >> 3, rc = (tid & 7) * 8, krs = KSWZ(rr, 256 + rc * 2);
    const unsigned glo = (unsigned)(sr * KVS + sc) * 2u, gro = (unsigned)(rr * KRS + rc) * 2u;
    const int vb0 = (int)(uintptr_t)V_lds + v_rd_base(lane);
    QRP_DECL;
#define RESC(a) do { if (__any((a) < 1.f)) { if (hi == 0) al_l[r32] = (a); asm volatile("s_waitcnt lgkmcnt(0)" ::: "memory");              \
                     for (int d_ = 0; d_ < 4; ++d_) for (int r = 0; r < 16; ++r) o[d_][r] *= al_l[crow(r, hi)]; } } while (0)
#define KBASE(t) ((t) * KVBLK)
#define MASKT(P0_, P1_, t) do { const int kb_ = KBASE(t); if (kb_ + KVBLK - 1 > qlo) mask_tile(P0_, P1_, qm - kb_, (unsigned)W); } while (0)
    constexpr int NQL = 8;
#define SEAM_K0() do { VMWN(NQL); SWRITE_K(0); SBAR(); SLOAD_V(nxt, 0); SBAR(); } while (0)
    f32x16 pA0, pA1, pB0, pB1; float mnA, mnB, alA, alB; bf16x8 pa0, pa1, pa2, pa3;
    VMW(); SWRITE_V(0); SBAR();
    if (NT > 1) { SLOAD_K(cur, KBASE(1)); }
    SBAR(); qkt<0>(pA0, pA1, K_lds, r32, hi, S.qr, qrp);
    if (NT > 1) { VMW(); SWRITE_K(1); SBAR(); SLOAD_V(cur, KBASE(1)); }
    MASKT(pA0, pA1, 0); partialSM(pA0, pA1, m_reg, mnA, alA);
    if (NT > 1) { VMW(); SWRITE_V(1); SBAR(); if (NT > 2) SLOAD_K(cur, KBASE(2)); }
    __syncthreads();
#define HALF_STEP(PX0, PX1, mnX, alX, PY0, PY1, alY, t, KB, VB, SB) do {                                                      \
        SBAR(); qkt<KB>(PX0, PX1, K_lds, r32, hi, S.qr, qrp);                                                                      \
        finishSM(PY0, PY1, alY, l_reg, pa0, pa1, pa2, pa3); SBAR();                                                           \
        if ((t) + 1 < NT) { VMW(); SWRITE_K(SB); SBAR(); SLOAD_V(cur, KBASE((t) + 1)); SBAR(); }                              \
        pv_tile<VB>(o, vb0, pa0, pa1, pa2, pa3); MASKT(PX0, PX1, (t)); partialSM(PX0, PX1, m_reg, mnX, alX);                  \
        __syncthreads();                                                                                                      \
        if ((t) + 1 < NT) { VMW(); SWRITE_V(SB); SBAR(); if ((t) + 2 < NT) SLOAD_K(cur, KBASE((t) + 2)); }                    \
        RESC(alX); __syncthreads(); } while (0)
    for (int t = 1; t + 1 < NT; t += 2) {
        HALF_STEP(pB0, pB1, mnB, alB, pA0, pA1, alA, t, 1, 0, 0);
        HALF_STEP(pA0, pA1, mnA, alA, pB0, pB1, alB, t + 1, 0, 1, 1);
    }
    const bool even = (NT & 1) == 0;
    if (even) { SBAR(); qkt<1>(pB0, pB1, K_lds, r32, hi, S.qr, qrp); SBAR(); }
    SLOAD_K(nxt, 0); SBAR();
    QLOAD(nxt);
    SBAR();
    finishSM(pA0, pA1, alA, l_reg, pa0, pa1, pa2, pa3); SBAR();
    pv_tile<0>(o, vb0, pa0, pa1, pa2, pa3);
    if (even) { MASKT(pB0, pB1, NT - 1); partialSM(pB0, pB1, m_reg, mnB, alB); __syncthreads(); RESC(alB);
        finishSM(pB0, pB1, alB, l_reg, pa0, pa1, pa2, pa3); SBAR(); pv_tile<1>(o, vb0, pa0, pa1, pa2, pa3); }
    SBAR(); SEAM_K0();
    if (hi == 0) li_l[r32] = l_reg; asm volatile("s_waitcnt lgkmcnt(0)" ::: "memory");
    float rli[16];
#pragma unroll
    for (int r = 0; r < 16; ++r) rli[r] = __builtin_amdgcn_rcpf(li_l[crow(r, hi)]);
    bf16_t* Ow = cur.O + (size_t)(wid * QBLK) * 64;
#pragma unroll
    for (int r = 0; r < 16; ++r) { const int orow = crow(r, hi);
#pragma unroll
        for (int d0 = 0; d0 < 4; ++d0) { const float v = o[d0][r] * rli[r];
            const float vn = __shfl_xor(v, 1);
            if ((r32 & 1) == 0) *(unsigned*)(Ow + ((size_t)(d0 >> 1) * 256 + orow) * 64 + (d0 & 1) * 32 + r32) = cvt_pk_bf16(v, vn); } }
    QRLOAD(nxt);
    __syncthreads();
#undef RESC
#undef KBASE
#undef MASKT
#undef SEAM_K0
#undef HALF_STEP
}
#undef VMW
#undef VMWN
#undef SLOAD_K
#undef SLOAD_V
#undef SWRITE_K
#undef SWRITE_V
#undef QLOAD
#undef QRLOAD
#undef QRP_DECL

__device__ __forceinline__ void decode(int L, int& bh, int& x) { const int xcd = L & 7, k = (L >> 3) & 63, gi = k >> 3, r = k & 7; bh = gi * 8 + xcd; x = r; }
__device__ __forceinline__ BlockRef mkref(int bh, int qb, const bf16_t* Q, const bf16_t* KV, const bf16_t* KR, bf16_t* O) {
    const int b = bh >> 4, h = bh & 15; BlockRef r;
    r.Q = Q + ((size_t)(b * NH + h) * SEQ + (size_t)qb * QB) * QS; r.O = O + ((size_t)(b * (SEQ / QB) + qb) * (OS / 64) + 2 * h) * (256 * 64);
    r.K = KV + (size_t)b * SEQ * KVS + h * 256; r.V = r.K + 128; r.R = KR + (size_t)b * SEQ * KRS; r.P0 = qb * QB;
    return r;
}
__device__ __forceinline__ void attn_phase(char* lds, const bf16_t* Q, const bf16_t* KV, const bf16_t* KR, bf16_t* O) {
    constexpr int total = 512 * REP_ATT; const int stride = gridDim.x;
    int L = blockIdx.x; if (L >= total) return;
    int bh, x; decode(L, bh, x); int pass = 0;
    BlockRef cur = mkref(bh, x, Q, KV, KR, O);
    Seam S;
    prime(cur, lds, S);
    for (;;) {
        const bool more_pass = pass == 0, more_item = L + stride < total, last = !more_pass && !more_item;
        int bhn = bh, xn = x, passn = pass + 1, Ln = L;
        if (!more_pass) { passn = 0; Ln = more_item ? L + stride : L; decode(Ln, bhn, xn); }
        const BlockRef nxt = last ? cur : mkref(bhn, passn ? 15 - xn : xn, Q, KV, KR, O);
        block(cur, nxt, lds, S);
        if (last) break;
        cur = nxt; bh = bhn; x = xn; pass = passn; L = Ln;
    }
}
}

__device__ __forceinline__ float wave_sum(float v) {
#pragma unroll
    for (int o = 1; o < 64; o <<= 1) v += __shfl_xor(v, o);
    return v;
}
template <int MODE> __device__ __forceinline__ int srccol(int n) {
    if (MODE == 1) { const int h = n / 192, w = n - h * 192; if (w < 128) return n; const int i = w - 128; return h * 192 + 128 + (i & 1) * 32 + (i >> 1); }
    if (MODE == 2) { if (n < 1024) return n; if (n >= 1088) return -1; const int i = n - 1024; return 1024 + (i & 1) * 32 + (i >> 1); }
    return n;
}
template <int MODE>
__device__ __forceinline__ void p0_item(const float* W, int K, int Nsrc, bf16_t* WT, LAS float* scr, int item, int nblk, int lane, const float* ks, const float* ns) {
    const int kb = item / nblk, nb = item - kb * nblk, k0 = 64 * kb, n0 = 32 * nb;
    const int nn = n0 + (lane & 31), sc = srccol<MODE>(nn);
    const float nsv = ns ? ns[nn] : 1.f;
    const char* ub = (const char*)(W + (size_t)k0 * Nsrc);
    const unsigned vo = (unsigned)((lane >> 5) * Nsrc + (sc >= 0 ? sc : 0)) * 4u;
    const float* ksp = ks ? ks + k0 + (lane >> 5) : nullptr;
#pragma unroll 16
    for (int i = 0; i < 32; ++i) { float v = 0.f;
        if (sc >= 0) { v = *(const float*)(ub + (size_t)(2 * i) * Nsrc * 4 + vo) * nsv; if (ks) v *= ksp[2 * i]; }
        scr[(2 * i + (lane >> 5)) * 33 + (lane & 31)] = v; }
    asm volatile("s_waitcnt lgkmcnt(0)" ::: "memory");
    const int c = lane & 7;
#pragma unroll
    for (int j = 0; j < 4; ++j) { const int n = (lane >> 3) + 8 * j; const LAS float* s = scr + (8 * c) * 33 + n;
        u32x4 o; o.x = cvt_pk_bf16(s[0 * 33], s[1 * 33]); o.y = cvt_pk_bf16(s[2 * 33], s[3 * 33]); o.z = cvt_pk_bf16(s[4 * 33], s[5 * 33]); o.w = cvt_pk_bf16(s[6 * 33], s[7 * 33]);
        *(u32x4*)(WT + (size_t)(n0 + n) * K + k0 + 8 * c) = o; }
    asm volatile("s_waitcnt lgkmcnt(0)" ::: "memory");
}

struct Conv { const float* W; bf16_t* WT; const float* ks; const float* ns; int K, N, mode, nblk; int tiled = 0; };
__device__ __forceinline__ int dstrow(int mode, int c) {
    if (mode == 1) { const int h = c / 192, w = c - h * 192; if (w < 128) return c; const int is = w - 128; return h * 192 + 128 + 2 * (is & 31) + (is >> 5); }
    if (mode == 2) { if (c < 1024) return c; const int is = c - 1024; return 1024 + 2 * (is & 31) + (is >> 5); }
    return c;
}
__device__ __forceinline__ void conv_task(const Conv& d, int task, int lane) {
    const int kb = task / d.nblk, nb = task - kb * d.nblk, k0 = kb * 16, n = nb * 256 + lane * 4;
    if (n >= d.N) return;
    const char* ub = (const char*)(d.W + (size_t)k0 * d.N); const unsigned vo = (unsigned)n * 4u;
    f32x4 v[16];
#pragma unroll
    for (int r = 0; r < 16; ++r) v[r] = *(const f32x4*)(ub + (size_t)r * d.N * 4 + vo);
    if (d.ks) {
#pragma unroll
        for (int r = 0; r < 16; ++r) v[r] = v[r] * d.ks[k0 + r]; }
    if (d.ns) { const f32x4 nv = *(const f32x4*)(d.ns + n);
#pragma unroll
        for (int r = 0; r < 16; ++r) v[r] = v[r] * nv; }
#pragma unroll
    for (int j = 0; j < 4; ++j) { const int dr = dstrow(d.mode, n + j);
        bf16_t* o = d.tiled ? d.WT + (((size_t)(dr >> 8) * (d.K >> 6) + (k0 >> 6)) * 256 + (dr & 255)) * 64 + (k0 & 63) : d.WT + (size_t)dr * d.K + k0;
        u32x4 w0, w1; w0.x = cvt_pk_bf16(v[0][j], v[1][j]); w0.y = cvt_pk_bf16(v[2][j], v[3][j]); w0.z = cvt_pk_bf16(v[4][j], v[5][j]); w0.w = cvt_pk_bf16(v[6][j], v[7][j]);
        w1.x = cvt_pk_bf16(v[8][j], v[9][j]); w1.y = cvt_pk_bf16(v[10][j], v[11][j]); w1.z = cvt_pk_bf16(v[12][j], v[13][j]); w1.w = cvt_pk_bf16(v[14][j], v[15][j]);
        *(u32x4*)o = w0; *(u32x4*)(o + 8) = w1; }
}

#define XB_TMO      128
#define XB_XCNT(j)  (256  + 64 * (j))
#define XB_XSUB(j)  (1280 + 64 * (j))
#define XB_XGEN(j)  (2304 + 64 * (j))
#define XB_TOP      3328
#define XB_TOPGEN   3392
#define XCD_BAR_WORDS 3456
#define XB_SPIN_CAP (1u << 18)

__device__ __forceinline__ unsigned xb_ld(unsigned* p)              { return __hip_atomic_load(p, __ATOMIC_RELAXED, __HIP_MEMORY_SCOPE_AGENT); }
__device__ __forceinline__ unsigned xb_add(unsigned* p, unsigned v) { return __hip_atomic_fetch_add(p, v, __ATOMIC_RELAXED, __HIP_MEMORY_SCOPE_AGENT); }
__device__ __forceinline__ unsigned xb_xcc_id() { return (unsigned)__builtin_amdgcn_s_getreg((3 << 11) | 20) & 0xFu; }
#define XB_SPIN(cond, bar) do { unsigned _sp = 0; while (cond) { __builtin_amdgcn_s_sleep(1); \
    if ((++_sp & 255u) == 0u) { if (xb_ld(&(bar)[XB_TMO])) break; if (_sp > XB_SPIN_CAP) { atomicAdd(&(bar)[XB_TMO], 1u); break; } } } } while (0)

struct XcdBarrier {
    unsigned* bar; unsigned x;
    volatile LAS unsigned* st;
};

__device__ __forceinline__ XcdBarrier xcd_barrier_post(unsigned* bar, volatile LAS unsigned* st) {
    XcdBarrier b; b.bar = bar; b.x = xb_xcc_id(); b.st = st;
    if (threadIdx.x == 0) (void)xb_add(&bar[XB_XCNT(b.x)], 1u);
    return b;
}
__device__ __forceinline__ void xcd_barrier_complete(unsigned* bar, unsigned x, unsigned& nloc, unsigned& nx) {
    const unsigned G = gridDim.x * gridDim.y * gridDim.z;
    unsigned sum, cnt, mine, sp = 0u;
    for (;;) {
        sum = 0u; cnt = 0u; mine = 0u;
#pragma unroll
        for (unsigned j = 0; j < 16; ++j) { const unsigned c = xb_ld(&bar[XB_XCNT(j)]); sum += c; cnt += (c > 0u) ? 1u : 0u; mine = (j == x) ? c : mine; }
        if (sum == G) break;
        __builtin_amdgcn_s_sleep(1);
        if ((++sp & 255u) == 0u) { if (xb_ld(&bar[XB_TMO])) break; if (sp > XB_SPIN_CAP) { atomicAdd(&bar[XB_TMO], 1u); break; } }
    }
    nloc = mine > 0u ? mine : 1u; nx = cnt > 0u ? cnt : 1u;
}

__device__ __forceinline__ void xcd_barrier(const XcdBarrier& b) {
    asm volatile("s_waitcnt vmcnt(0)" ::: "memory");
    __syncthreads();
    if (threadIdx.x == 0) {
        unsigned* bar = b.bar;
        __builtin_amdgcn_s_waitcnt(0);
        unsigned nloc = b.st[0], nx = b.st[1];
        if (nloc == 0u) { xcd_barrier_complete(bar, b.x, nloc, nx); b.st[0] = nloc; b.st[1] = nx; }
        const unsigned old = xb_add(&bar[XB_XSUB(b.x)], 1u);
        const unsigned gen = old / nloc;
        if (old + 1u == (gen + 1u) * nloc) {
            __builtin_amdgcn_fence(__ATOMIC_RELEASE, "agent");
            asm volatile("s_waitcnt vmcnt(0)" ::: "memory");
            const unsigned og = xb_add(&bar[XB_TOP], 1u);
            const unsigned tg = og / nx;
            if (og + 1u == (tg + 1u) * nx) xb_add(&bar[XB_TOPGEN], 1u);
            else XB_SPIN(xb_ld(&bar[XB_TOPGEN]) == tg, bar);
            __builtin_amdgcn_fence(__ATOMIC_ACQUIRE, "agent");
            xb_add(&bar[XB_XGEN(b.x)], 1u);
            asm volatile("s_waitcnt vmcnt(0)" ::: "memory");
        } else {
            XB_SPIN(xb_ld(&bar[XB_XGEN(b.x)]) == gen, bar);
            __builtin_amdgcn_fence(__ATOMIC_ACQUIRE, "agent");
            asm volatile("s_waitcnt vmcnt(0)" ::: "memory");
        }
    }
    __syncthreads();
}

__device__ __forceinline__ f32x4 ldh4(const bf16_t* p) { const u32x2 w = *(const u32x2*)p; f32x4 r; r[0] = __uint_as_float(w.x << 16); r[1] = __uint_as_float(w.x & 0xffff0000u); r[2] = __uint_as_float(w.y << 16); r[3] = __uint_as_float(w.y & 0xffff0000u); return r; }
struct Params {
    const float* x; const int* pos; const float* ln_mix; const float* ln_mlp; const float* w_dqkv; const float* q_norm; const float* kv_norm;
    const float* w_uq; const float* w_ukv; const float* w_o; const float* w_pool; const float* pool_scale; const float* w_up; const float* w_down; const float* final_norm;
    float* out; unsigned char* ws;
};

#ifndef REP_P0
#define REP_P0 1
#endif
#ifndef REP_ATT
#define REP_ATT 1
#endif
#ifndef REP_UP
#define REP_UP 1
#endif
constexpr int LDS_TOTAL = STAT_LDS_OFF + 4096;
static_assert(att::LDS_BYTES <= 131072, "attention LDS");

__global__ void __launch_bounds__(512, 2) mega_fwd(Params p) {
    extern __shared__ __attribute__((aligned(16))) unsigned char lds[];
    cg::grid_group grid = cg::this_grid();
    LAS unsigned char* ldsl = (LAS unsigned char*)lds;
    const int tid = threadIdx.x, lane = tid & 63, wave = __builtin_amdgcn_readfirstlane(tid >> 6);
    const int G = gridDim.x, bid = blockIdx.x;
    const int gw = bid * 8 + wave, NGW = G * 8;
    unsigned char* ws = p.ws;
    ssq_t* ctl = (ssq_t*)(ws + WS_CTL);
    bf16_t* Wdqkv = (bf16_t*)(ws + WS_WDQKV); bf16_t* Wuq = (bf16_t*)(ws + WS_WUQ); bf16_t* Wukv = (bf16_t*)(ws + WS_WUKV); bf16_t* Wo = (bf16_t*)(ws + WS_WO);
    bf16_t* Wpool = (bf16_t*)(ws + WS_WPOOL); bf16_t* Wup0 = (bf16_t*)(ws + WS_WUP0); bf16_t* Wdn0 = (bf16_t*)(ws + WS_WDN0);
    bf16_t* Wup1 = (bf16_t*)p.out; bf16_t* Wdn1 = (bf16_t*)p.out + (size_t)DM * FF;
    float* rope = (float*)(ws + WS_ROPE);
    bf16_t* XB = (bf16_t*)(ws + WS_XB); bf16_t* Qb = (bf16_t*)(ws + WS_Q); bf16_t* KVb = (bf16_t*)(ws + WS_KV); bf16_t* CQKV = (bf16_t*)(ws + WS_CQKV);
    bf16_t* Ob = (bf16_t*)(ws + WS_O); bf16_t* KRb = (bf16_t*)(ws + WS_KR); bf16_t* Hb = (bf16_t*)(ws + WS_H); bf16_t* Yb = (bf16_t*)(ws + WS_Y);
    LAS float* scr = (LAS float*)(ldsl + wave * 16384);
    volatile LAS unsigned* misc = (volatile LAS unsigned*)(ldsl + 131072 + 512);
    if (tid < 8) misc[tid] = 0u;
    __syncthreads();
    XcdBarrier xbar = xcd_barrier_post((unsigned*)(ws + WS_BAR), misc);

    for (int rep_ = 0; rep_ < REP_P0; ++rep_) {
        for (int i = bid * 512 + tid; i < SS_END - T; i += G * 512) ctl[T + i] = 0ull;
        for (int i = bid * 512 + tid; i < T * 32; i += G * 512) {
            const int t = i >> 5, j = i & 31; const float inv = 1.0f / powf(10000.0f, (float)(2 * j) * (1.0f / 64.0f));
            const float ang = (float)p.pos[t] * inv; float sn, cs; sincosf(ang, &sn, &cs);
            rope[(size_t)t * 64 + j] = cs; rope[(size_t)t * 64 + 32 + j] = sn;
        }
        for (int m = gw; m < T; m += NGW) {
            const f32x4* xr = (const f32x4*)(p.x + (size_t)m * DM) + lane; float s = 0.f;
            f32x4 xv[8];
#pragma unroll
            for (int j = 0; j < 8; ++j) xv[j] = xr[64 * j];
            asm volatile("" ::: "memory");
#pragma unroll
            for (int j = 0; j < 8; ++j) { const f32x4 v = xv[j]; s += dot4(v); u32x2 w; w.x = cvt_pk_bf16(v[0], v[1]); w.y = cvt_pk_bf16(v[2], v[3]); *(u32x2*)(XB + xb_off(m, 256 * j + 4 * lane)) = w; }
            s = wave_sum(s); if (lane == 0) ctl[SS_X + m] = ssq_fix(s);
        }
        for (int i = bid * 512 + tid; i < (DM / 64) * 1536; i += G * 512) { const int kt = i / 1536, r = i - kt * 1536;
            ((u32x4*)(Wdqkv + (((size_t)4 * (DM / 64) + kt) * 256 + 64) * 64))[r] = (u32x4){0u, 0u, 0u, 0u}; }
        for (int it = gw; it < (DM / 16) * 5; it += NGW) { const Conv d{p.w_dqkv, Wdqkv, p.ln_mix, nullptr, DM, 1088, 2, 5, 1}; conv_task(d, it, lane); }
    }
    if (p.ws == nullptr) grid.sync();
    xcd_barrier(xbar);
    {
        const int NG1 = (G * 5) / 8;
        if (bid < NG1) {
            pg8::Gemm g{XB, Wdqkv, DM, DM, DM, 0, 1, 1}; pg8::StaticOrder S; S.init(T, NDQ, NG1, bid);
            EpiDqkv E{ctl + SS_X, ctl + SS_CQ, ctl + SS_CKV, CQKV, KRb, rope};
            pg8::gemm_phase(ldsl, g, S, E);
        }
        {
            constexpr int T_UQ = (512 / 16) * (NQ / 256), T_UKV = (512 / 16) * (NKV / 256), T_O = (DM / 16) * (DM / 256), T_PL = (512 / 16) * 2;
            constexpr int T_UP = (DM / 16) * (FF / 256), T_DN = (FF / 16) * (DM / 256);
            constexpr int NTASK = T_UQ + T_UKV + T_O + 4 * T_PL + 2 * T_UP + 2 * T_DN;
            unsigned* qctr = (unsigned*)(ws + WS_BAR) + 3800;
            for (;;) {
                unsigned it0 = 0u; if (lane == 0) it0 = __hip_atomic_fetch_add(qctr, 2u, __ATOMIC_RELAXED, __HIP_MEMORY_SCOPE_AGENT);
                const int itb = __builtin_amdgcn_readfirstlane((int)it0);
                if (itb >= NTASK) break;
                for (int it = itb; it < itb + 2 && it < NTASK; ++it) {
                    int r = it; Conv d;
                    if (r < T_UQ) d = Conv{p.w_uq, Wuq, p.q_norm, nullptr, 512, NQ, 1, NQ / 256, 1};
                    else if ((r -= T_UQ) < T_UKV) d = Conv{p.w_ukv, Wukv, p.kv_norm, nullptr, 512, NKV, 0, NKV / 256, 1};
                    else if ((r -= T_UKV) < T_O) d = Conv{p.w_o, Wo, nullptr, nullptr, DM, DM, 0, DM / 256, 1};
                    else if ((r -= T_O) < 4 * T_PL) { const int g = r / T_PL; r -= g * T_PL; d = Conv{p.w_pool + (size_t)g * 512 * 512, Wpool + (size_t)g * 512 * 512, nullptr, p.pool_scale + g * 512, 512, 512, 0, 2, 1}; }
                    else if ((r -= 4 * T_PL) < T_UP) d = Conv{p.w_up, Wup0, p.ln_mlp, nullptr, DM, FF, 0, FF / 256, 1};
                    else if ((r -= T_UP) < T_DN) d = Conv{p.w_down, Wdn0, nullptr, nullptr, FF, DM, 0, DM / 256, 1};
                    else if ((r -= T_DN) < T_UP) d = Conv{p.w_up + (size_t)DM * FF, Wup1, p.ln_mlp + DM, nullptr, DM, FF, 0, FF / 256, 1};
                    else { r -= T_UP; d = Conv{p.w_down + (size_t)FF * DM, Wdn1, nullptr, nullptr, FF, DM, 0, DM / 256, 1}; }
                    conv_task(d, r, lane);
                }
            }
        }
    }
    xcd_barrier(xbar);
    {
        pg8::Gemm g{CQKV, Wuq, 1024, 512, 512, 0, 1, 1, 16}; pg8::StaticOrder S; S.init(T, NQ, G, bid);
        EpiUq E{ctl + SS_CQ, Qb, rope};
        pg8::gemm_phase(ldsl, g, S, E);
    }
    {
        pg8::Gemm g{CQKV + 8 * 256 * 64, Wukv, 1024, 512, 512, 0, 1, 1, 16}; pg8::StaticOrder S; S.init(T, NKV, G, bid);
        EpiScale<0> E{ctl + SS_CKV, 1.f / 512.f, KVb, NKV};
        pg8::gemm_phase(ldsl, g, S, E);
    }
    xcd_barrier(xbar);
    att::attn_phase((char*)lds, Qb, KVb, KRb, Ob);
    xcd_barrier(xbar);
    {
        pg8::Gemm g{Ob, Wo, DM, DM, DM, 0, 1, 1}; pg8::StaticOrder S; S.init(T, DM, G, bid);
        EpiRes2<false, false> E{XB, XB, ctl + SS_H1};
        pg8::gemm_phase(ldsl, g, S, E);
    }
    xcd_barrier(xbar);
    for (int rep_ = 0; rep_ < REP_UP; ++rep_) {
        pg8::Gemm g{XB, Wup0, DM, DM, DM, 0, 1, 1}; pg8::StaticOrder S; S.init(T, FF, G, bid);
        EpiScale<1> E{ctl + SS_H1, 1.f / DM, Hb, FF};
        pg8::gemm_phase(ldsl, g, S, E);
    }
    xcd_barrier(xbar);
    {
        pg8::Gemm g{Hb, Wdn0, FF, FF, FF, 0, 1, 1}; pg8::StaticOrder S; S.init(T, DM, G, bid);
        EpiRes2<false, false> E{XB, XB, ctl + SS_H2};
        pg8::gemm_phase(ldsl, g, S, E);
    }
    xcd_barrier(xbar);
    {
        for (int it = gw; it < (T / 32) * 8; it += NGW) {
            const int tch = it >> 3, cs = it & 7, c = cs * 256 + lane * 4, w = 2 << (cs >> 1);
            const int t0 = tch * 32, s0 = t0 & (SEQ - 1);
            const f32x4 gv = *(const f32x4*)(p.ln_mix + DM + c);
            const bf16_t* hp = XB; const ssq_t* ssr = ctl + SS_H2;
            f32x4 run = {0.f, 0.f, 0.f, 0.f};
            for (int j = 1; j < w; ++j) if (s0 - j >= 0) { const int t = t0 - j; const float rs = rsqrtf(ssq_f(ssr[t]) * (1.f / DM) + EPS); run += ldh4(hp + xb_off(t, c)) * gv * rs; }
            for (int i0 = 0; i0 < 32; i0 += 8) {
                f32x4 cur[8], old[8];
#pragma unroll
                for (int k = 0; k < 8; ++k) { const int t = t0 + i0 + k; cur[k] = ldh4(hp + xb_off(t, c));
                    const int so = s0 + i0 + k - (w - 1); const int to = so >= 0 ? t - (w - 1) : t; old[k] = ldh4(hp + xb_off(to, c)); }
                asm volatile("" ::: "memory");
#pragma unroll
                for (int k = 0; k < 8; ++k) { const int i = i0 + k, t = t0 + i; const float rs = rsqrtf(ssq_f(ssr[t]) * (1.f / DM) + EPS);
                    const f32x4 v = cur[k] * gv * rs; run += v;
                    const int cn = (s0 + i + 1) < w ? (s0 + i + 1) : w; const f32x4 y = run * (1.f / (float)cn) - v;
                    u32x2 o; o.x = cvt_pk_bf16(y[0], y[1]); o.y = cvt_pk_bf16(y[2], y[3]); *(u32x2*)(Yb + xb_off(t, c)) = o;
                    const int so = s0 + i - (w - 1);
                    if (so >= 0) { const int to = t - (w - 1); const float ro = rsqrtf(ssq_f(ssr[to]) * (1.f / DM) + EPS); run -= old[k] * gv * ro; } }
            }
        }
    }
    xcd_barrier(xbar);
    {
        pg8::Gemm g{Yb, Wpool, DM, 512, 512, 1, 1, 1, 32}; pg8::StaticOrder S; S.init(T, DM, G, bid);
        EpiRes2<false, false> E{XB, XB, ctl + SS_H3};
        pg8::gemm_phase(ldsl, g, S, E);
    }
    xcd_barrier(xbar);
    {
        pg8::Gemm g{XB, Wup1, DM, DM, DM, 0, 1, 1}; pg8::StaticOrder S; S.init(T, FF, G, bid);
        EpiScale<1> E{ctl + SS_H3, 1.f / DM, Hb, FF};
        pg8::gemm_phase(ldsl, g, S, E);
    }
    xcd_barrier(xbar);
    {
        pg8::Gemm g{Hb, Wdn1, FF, FF, FF, 0, 1, 1}; pg8::StaticOrder S; S.init(T, DM, G, bid);
        EpiRes2<false, false> E{XB, XB, ctl + SS_H4};
        pg8::gemm_phase(ldsl, g, S, E);
    }
    xcd_barrier(xbar);
    {
        f32x4 gn[8];
#pragma unroll
        for (int j = 0; j < 4; ++j) { gn[2 * j] = ((const f32x4*)p.final_norm)[2 * lane + 128 * j]; gn[2 * j + 1] = ((const f32x4*)p.final_norm)[2 * lane + 128 * j + 1]; }
        for (int m = gw; m < T; m += NGW) {
            const float rs = rsqrtf(ssq_f(ctl[SS_H4 + m]) * (1.f / DM) + EPS);
            f32x4* orow = (f32x4*)(p.out + (size_t)m * DM) + 2 * lane;
            u32x4 hw[4];
#pragma unroll
            for (int j = 0; j < 4; ++j) hw[j] = *(const u32x4*)(XB + xb_off(m, 512 * j + 8 * lane));
            asm volatile("" ::: "memory");
#pragma unroll
            for (int j = 0; j < 4; ++j) { orow[128 * j] = unpk_lo(hw[j]) * gn[2 * j] * rs; orow[128 * j + 1] = unpk_hi(hw[j]) * gn[2 * j + 1] * rs; }
        }
    }
}

extern "C" void kernel_launch(void* const* d_in, const int* in_sizes, int n_in, void* d_out, int out_size, void* d_ws, size_t ws_size, hipStream_t stream) {
    static int grid_blocks = 0;
    if (grid_blocks == 0) {
        if (n_in != 15 || in_sizes[0] != T * DM || out_size != T * DM || ws_size < WS_END) {
            fprintf(stderr, "kernel_launch: unexpected shapes (n_in %d, in0 %d, out %d, ws %zu)\n", n_in, n_in > 0 ? in_sizes[0] : -1, out_size, ws_size); grid_blocks = -1; return; }
        int dev = 0, cus = 0, per_cu = 0;
        (void)hipGetDevice(&dev); (void)hipDeviceGetAttribute(&cus, hipDeviceAttributeMultiprocessorCount, dev);
        if (hipFuncSetAttribute((const void*)mega_fwd, hipFuncAttributeMaxDynamicSharedMemorySize, LDS_TOTAL) != hipSuccess) fprintf(stderr, "kernel_launch: hipFuncSetAttribute failed\n");
        if (hipOccupancyMaxActiveBlocksPerMultiprocessor(&per_cu, (const void*)mega_fwd, 512, LDS_TOTAL) != hipSuccess || per_cu < 1) per_cu = 1;
        (void)hipGetLastError();
        if (cus <= 0) cus = 256;
        grid_blocks = cus * per_cu;
    }
    if (grid_blocks < 0) return;
    if (hipMemsetAsync((char*)d_ws + WS_BAR, 0, BAR_BYTES, stream) != hipSuccess) { fprintf(stderr, "kernel_launch: hipMemsetAsync failed\n"); return; }
    Params p{};
    p.x = (const float*)d_in[0]; p.pos = (const int*)d_in[1]; p.ln_mix = (const float*)d_in[2]; p.ln_mlp = (const float*)d_in[3]; p.w_dqkv = (const float*)d_in[4];
    p.q_norm = (const float*)d_in[5]; p.kv_norm = (const float*)d_in[6]; p.w_uq = (const float*)d_in[7]; p.w_ukv = (const float*)d_in[8]; p.w_o = (const float*)d_in[9];
    p.w_pool = (const float*)d_in[10]; p.pool_scale = (const float*)d_in[11]; p.w_up = (const float*)d_in[12]; p.w_down = (const float*)d_in[13]; p.final_norm = (const float*)d_in[14];
    p.out = (float*)d_out; p.ws = (unsigned char*)d_ws;
    void* args[] = {&p};
    hipError_t e = hipLaunchCooperativeKernel((const void*)mega_fwd, dim3(grid_blocks), dim3(512), args, LDS_TOTAL, stream);
    if (e != hipSuccess) fprintf(stderr, "kernel_launch: cooperative launch failed: %s (grid %d)\n", hipGetErrorString(e), grid_blocks);
}
```

```cpp
#include <hip/hip_runtime.h>
#include <hip/hip_cooperative_groups.h>
#include <hip/hip_bf16.h>
#include <cstdio>
#include <cstdint>
namespace cg = cooperative_groups;
#ifndef REP_P0
#define REP_P0 1
#endif
#ifndef REP_ATT
#define REP_ATT 1
#endif
#ifndef REP_UP
#define REP_UP 1
#endif

#define LAS __attribute__((address_space(3)))
typedef unsigned short bf16_t;
typedef short bf16x8 __attribute__((ext_vector_type(8)));
typedef short s16x4 __attribute__((ext_vector_type(4)));
typedef float f32x4 __attribute__((ext_vector_type(4)));
typedef float f32x16 __attribute__((ext_vector_type(16)));
typedef unsigned u32x4 __attribute__((ext_vector_type(4)));
typedef unsigned u32x2 __attribute__((ext_vector_type(2)));
typedef unsigned long long ssq_t;
__device__ __forceinline__ ssq_t ssq_fix(float s) { return (ssq_t)(s * 1048576.0f + 0.5f); }
__device__ __forceinline__ float ssq_f(ssq_t q) { return (float)q * (1.0f / 1048576.0f); }

constexpr int T = 16384, SEQ = 4096, DM = 2048, FF = 8192, NH = 16;
constexpr int NDQ = 1280;
constexpr int NQ = 3072, NKV = 4096;
constexpr float EPS = 1e-6f;

constexpr size_t MiB = 1u << 20;
constexpr size_t WS_CTL = 0;
constexpr size_t WS_WDQKV = 1 * MiB, WS_WUQ = 6 * MiB, WS_WUKV = 9 * MiB, WS_WO = 13 * MiB, WS_WPOOL = 21 * MiB, WS_WUP0 = 23 * MiB, WS_WDN0 = 55 * MiB;
constexpr size_t WS_ROPE = 87 * MiB, WS_XB = 91 * MiB;
constexpr size_t WS_Q = 155 * MiB, WS_KV = 251 * MiB, WS_CQKV = 379 * MiB, WS_O = 411 * MiB, WS_KR = 475 * MiB, WS_END = 477 * MiB;
constexpr size_t WS_H = 155 * MiB, WS_Y = 155 * MiB, WS_WUP1 = 411 * MiB, WS_WDN1 = 443 * MiB;
constexpr size_t WS_BAR = 960 * 1024, BAR_BYTES = 16384;
constexpr int SS_X = 0, SS_CQ = T, SS_CKV = 2 * T, SS_H1 = 3 * T, SS_H2 = 4 * T, SS_H3 = 5 * T, SS_H4 = 6 * T, SS_END = 7 * T;

__device__ __forceinline__ size_t xb_off(int row, int col) { return (((size_t)(row >> 8) * (DM / 64) + (col >> 6)) * 256 + (row & 255)) * 64 + (col & 63); }
__device__ __forceinline__ unsigned cvt_pk_bf16(float lo, float hi) { unsigned r; asm volatile("v_cvt_pk_bf16_f32 %0, %1, %2" : "=v"(r) : "v"(lo), "v"(hi)); return r; }

constexpr int STAT_LDS_OFF = 131072 + 1024;
namespace pg8 {
#define PG8_LAS __attribute__((address_space(3)))
constexpr int BM = 256, BK = 64, HALF = 128, HTB = HALF * BK * 2  , STAGE_BYTES = 8 * HTB, NXCD = 8, WGM = 4;

__host__ __device__ __forceinline__ int lds_byte(int r, int c) { const int st = (r >> 4) * 2 + (c >> 5), rr = r & 15, cc = c & 31, ob = rr * 64 + cc * 2; return st * 1024 + (ob ^ (((ob >> 9) & 1) << 5)); }
__host__ __device__ __forceinline__ void stage_rc(int b, int& R, int& C) { const int st = b / 1024, sb = b % 1024, swz = sb ^ (((sb >> 9) & 1) << 5); R = (st >> 1) * 16 + swz / 64; C = (st & 1) * 32 + (swz % 64) / 2; }
__host__ __device__ __forceinline__ int perm32(int rho) { const int n = rho >> 4, i = rho & 15; return 8 * (i >> 2) + 4 * n + (i & 3); }

struct Unit { int pm, pn; };
struct Gemm { const bf16_t* A; const bf16_t* Bt; int lda, ldb, K, grp; int ta = 0, tb = 0, apan = 0; };

struct StaticOrder {
    int nM, nN, nwg, G, c;
    __host__ __device__ void init(int M, int N, int G_, int c_) { nM = M / BM; nN = N / BM; nwg = nM * nN; G = G_; c = c_; }
    __host__ __device__ bool next(int i, Unit& u) const {
        const long L = (long)i * G + c; if (L >= nwg) return false;
        int wgid = (int)L; { const int q = nwg / NXCD, r = nwg % NXCD, xcd = wgid % NXCD, off = wgid / NXCD; wgid = (xcd < r ? xcd * (q + 1) : r * (q + 1) + (xcd - r) * q) + off; }
        const int nig = WGM * nN, gid = wgid / nig, fm = gid * WGM, gsz = (nM - fm) < WGM ? (nM - fm) : WGM;
        u.pm = fm + ((wgid % nig) % gsz); u.pn = (wgid % nig) / gsz; return true;
    }
};

template <class Epi, class Sched>
__device__ __forceinline__ void gemm_phase(PG8_LAS unsigned char* lds, const Gemm g, const Sched& S, const Epi& E) {
    int tid_ = threadIdx.x; asm volatile("" : "+v"(tid_));
    const int tid = tid_, wid = __builtin_amdgcn_readfirstlane(tid >> 6), lane = tid & 63, wr = wid >> 2, wc = wid & 3, fr = lane & 15, fq = lane >> 4;
    const int K = g.K, nt = K / BK;
    unsigned voffA[2], voffB[2];
#pragma unroll
    for (int i = 0; i < 2; ++i) { int R, C; stage_rc(tid * 16 + i * 8192, R, C); const int Rb = Epi::PERM ? ((R & ~31) + perm32(R & 31)) : R;
        voffA[i] = (unsigned)(R * (g.ta ? BK : g.lda) + C) * 2u; voffB[i] = (unsigned)(Rb * (g.tb ? BK : g.ldb) + C) * 2u; }
    const int rpa = g.ta ? BK : g.lda, rpb = g.tb ? BK : g.ldb;
    const size_t kstepA = g.ta ? (size_t)BM * BK * 2 : (size_t)(BK * 2), kstepB = g.tb ? (size_t)BM * BK * 2 : (size_t)(BK * 2);
    const size_t hstepA = (size_t)HALF * rpa * 2, hstepB = (size_t)HALF * rpb * 2;
    const size_t tstepA = g.ta ? (size_t)(g.apan ? g.apan : K / BK) * (BM * BK * 2) : 2 * hstepA, tstepB = g.tb ? (size_t)BM * K * 2 : 2 * hstepB;
    const unsigned ldsw = (unsigned)wid * 1024u;
    const int aoff = lds_byte(wr * 64 + fr, fq * 8), boff = lds_byte(wc * 32 + fr, fq * 8);
#define PG8_SA(b, h) (((b) * 2 + (h)) * HTB)
#define PG8_SB(b, h) ((4 + (b) * 2 + (h)) * HTB)
#define PG8_STAGE(bufoff, gbase, voff) do { _Pragma("unroll") for (int _i = 0; _i < 2; ++_i) \
        __builtin_amdgcn_global_load_lds((const unsigned*)((const char*)(gbase) + (voff)[_i]), (PG8_LAS unsigned*)(lds + (bufoff) + ldsw + _i * 8192), 16, 0, 0); } while (0)
#define PG8_LDA(dst, b, h) do { _Pragma("unroll") for (int m = 0; m < 4; ++m) _Pragma("unroll") for (int k = 0; k < 2; ++k) dst[m][k] = *(const PG8_LAS bf16x8*)(lds + PG8_SA(b, h) + aoff + m * 2048 + k * 1024); } while (0)
#define PG8_LDB(dst, b, h) do { _Pragma("unroll") for (int n = 0; n < 2; ++n) _Pragma("unroll") for (int k = 0; k < 2; ++k) dst[n][k] = *(const PG8_LAS bf16x8*)(lds + PG8_SB(b, h) + boff + n * 2048 + k * 1024); } while (0)
#define PG8_MMA(ai, bj, At, Bt) do { __builtin_amdgcn_s_setprio(1); _Pragma("unroll") for (int m = 0; m < 4; ++m) _Pragma("unroll") for (int n = 0; n < 2; ++n) _Pragma("unroll") for (int k = 0; k < 2; ++k) \
        acc[ai][bj][m][n] = __builtin_amdgcn_mfma_f32_16x16x32_bf16(Bt[n][k], At[m][k], acc[ai][bj][m][n], 0, 0, 0); __builtin_amdgcn_s_setprio(0); } while (0)
#define PG8_WAIT_V(n) asm volatile("s_waitcnt vmcnt(" #n ")" ::: "memory")
#define PG8_WAIT_L(n) asm volatile("s_waitcnt lgkmcnt(" #n ")" ::: "memory")
#define PG8_BAR __builtin_amdgcn_s_barrier()
#define PG8_SCHED __builtin_amdgcn_sched_barrier(0)
#define PG8_ABASE(u) ((const char*)g.A + (size_t)(u).pm * tstepA + (g.grp ? (size_t)((u).pn >> 1) * (g.ta ? (size_t)(K / BK) * (BM * BK * 2) : (size_t)K * 2) : (size_t)0))
    Unit cur, nxt; int ui = 0;
    if (!S.next(0, cur)) return;
    f32x4 acc[2][2][4][2];
#pragma unroll
    for (int a = 0; a < 2; ++a)
#pragma unroll
        for (int b = 0; b < 2; ++b)
#pragma unroll
            for (int m = 0; m < 4; ++m)
#pragma unroll
                for (int n = 0; n < 2; ++n) acc[a][b][m][n] = (f32x4){0.f, 0.f, 0.f, 0.f};
    bf16x8 At[4][2], B0[2][2], B1[2][2];
    const char* cA = PG8_ABASE(cur); const char* cB = (const char*)g.Bt + (size_t)cur.pn * tstepB;
    PG8_STAGE(PG8_SB(0, 0), cB, voffB); PG8_STAGE(PG8_SB(0, 1), cB + hstepB, voffB); PG8_STAGE(PG8_SA(0, 0), cA, voffA); PG8_STAGE(PG8_SA(0, 1), cA + hstepA, voffA);
    if (wr == 1) PG8_BAR;
    PG8_WAIT_V(2); PG8_BAR;
    PG8_STAGE(PG8_SB(1, 0), cB + kstepB, voffB); PG8_STAGE(PG8_SA(1, 0), cA + kstepA, voffA); PG8_STAGE(PG8_SB(1, 1), cB + hstepB + kstepB, voffB);
    PG8_WAIT_V(6); PG8_BAR;
    for (;;) {
        const bool has_next = S.next(ui + 1, nxt);
        const char* nA = has_next ? PG8_ABASE(nxt) : cA; const char* nB = has_next ? (const char*)g.Bt + (size_t)nxt.pn * tstepB : cB;
        for (int t = 0; t < nt; t += 2) {
            const bool last = (t == nt - 2);
            const char* a1 = cA + (size_t)(t + 1) * kstepA;
            const char* a2 = last ? nA : cA + (size_t)(t + 2) * kstepA; const char* b2 = last ? nB : cB + (size_t)(t + 2) * kstepB;
            const char* a3 = a2 + kstepA; const char* b3 = b2 + kstepB;
            if (Epi::NPRE && last) {
                const unsigned* src = (const unsigned*)(E.stat() + cur.pm * 256 + (wid & 3) * 64 + lane);
                __builtin_amdgcn_global_load_lds(src, (PG8_LAS unsigned*)(lds + STAT_LDS_OFF + (wid >> 2) * 2048 + (wid & 3) * 256), 4, 0, 0);
                __builtin_amdgcn_global_load_lds(src + 1, (PG8_LAS unsigned*)(lds + STAT_LDS_OFF + (wid >> 2) * 2048 + 1024 + (wid & 3) * 256), 4, 0, 0);
                PG8_SCHED; }
            PG8_LDB(B0, 0, 0); PG8_LDB(B1, 0, 1); PG8_SCHED; PG8_LDA(At, 0, 0); PG8_STAGE(PG8_SA(1, 1), a1 + hstepA, voffA);
            if (Epi::NPRE && last) PG8_WAIT_V(10); else PG8_WAIT_V(8);
            PG8_WAIT_L(0); PG8_BAR; PG8_MMA(0, 0, At, B0); PG8_MMA(0, 1, At, B1); PG8_BAR; PG8_SCHED;
            PG8_LDA(At, 0, 1); PG8_STAGE(PG8_SB(0, 0), b2, voffB); PG8_STAGE(PG8_SB(0, 1), b2 + hstepB, voffB); PG8_STAGE(PG8_SA(0, 0), a2, voffA);
            if (Epi::NPRE && last) PG8_WAIT_V(10); else PG8_WAIT_V(8);
            PG8_WAIT_L(0); PG8_BAR; PG8_MMA(1, 0, At, B0); PG8_MMA(1, 1, At, B1); PG8_BAR; PG8_SCHED;
            PG8_LDB(B0, 1, 0); PG8_LDB(B1, 1, 1); PG8_SCHED; PG8_LDA(At, 1, 0); PG8_STAGE(PG8_SA(0, 1), a2 + hstepA, voffA);
            PG8_WAIT_V(8); PG8_WAIT_L(0); PG8_BAR; PG8_MMA(0, 0, At, B0); PG8_MMA(0, 1, At, B1); PG8_BAR; PG8_SCHED;
            PG8_LDA(At, 1, 1); PG8_STAGE(PG8_SB(1, 0), b3, voffB); PG8_STAGE(PG8_SB(1, 1), b3 + hstepB, voffB); PG8_STAGE(PG8_SA(1, 0), a3, voffA);
            PG8_WAIT_V(8); PG8_WAIT_L(0); PG8_BAR; PG8_MMA(1, 0, At, B0); PG8_MMA(1, 1, At, B1); PG8_BAR; PG8_SCHED;
        }
        if (wr == 0) PG8_BAR;
        E(acc, cur, wr, wc, fr, fq, (const PG8_LAS unsigned*)(lds + STAT_LDS_OFF + wr * 2048));
        if (!has_next) break;
#pragma unroll
        for (int a = 0; a < 2; ++a)
#pragma unroll
            for (int b = 0; b < 2; ++b)
#pragma unroll
                for (int m = 0; m < 4; ++m)
#pragma unroll
                    for (int n = 0; n < 2; ++n) acc[a][b][m][n] = (f32x4){0.f, 0.f, 0.f, 0.f};
        cur = nxt; cA = nA; cB = nB; ++ui;
        if (wr == 1) PG8_BAR;
    }
    PG8_WAIT_V(0);
    PG8_BAR;
#undef PG8_ABASE
#undef PG8_SA
#undef PG8_SB
#undef PG8_STAGE
#undef PG8_LDA
#undef PG8_LDB
#undef PG8_MMA
#undef PG8_WAIT_V
#undef PG8_WAIT_L
#undef PG8_BAR
#undef PG8_SCHED
}
}

typedef const f32x4 (&AccRef)[2][2][4][2];
__device__ __forceinline__ float dot4(f32x4 v) { return (v[0] * v[0] + v[1] * v[1]) + (v[2] * v[2] + v[3] * v[3]); }
__device__ __forceinline__ u32x4 pack8v(f32x4 a, f32x4 b) { u32x4 w; w.x = cvt_pk_bf16(a[0], a[1]); w.y = cvt_pk_bf16(a[2], a[3]); w.z = cvt_pk_bf16(b[0], b[1]); w.w = cvt_pk_bf16(b[2], b[3]); return w; }
__device__ __forceinline__ void rope8(f32x4& v0, f32x4& v1, f32x4 cs, f32x4 sn) {
    f32x4 a, b;
    a[0] = v0[0] * cs[0] - v0[1] * sn[0]; a[1] = v0[1] * cs[0] + v0[0] * sn[0]; a[2] = v0[2] * cs[1] - v0[3] * sn[1]; a[3] = v0[3] * cs[1] + v0[2] * sn[1];
    b[0] = v1[0] * cs[2] - v1[1] * sn[2]; b[1] = v1[1] * cs[2] + v1[0] * sn[2]; b[2] = v1[2] * cs[3] - v1[3] * sn[3]; b[3] = v1[3] * cs[3] + v1[2] * sn[3];
    v0 = a; v1 = b;
}

struct EpiDqkv {
    static constexpr bool PERM = true;
    const ssq_t* ssx; ssq_t* sscq; ssq_t* ssckv; bf16_t* cqkv; bf16_t* kr; const float* rope;
    static constexpr int NPRE = 8;
    __device__ __forceinline__ const ssq_t* stat() const { return ssx; }
    __device__ __forceinline__ void operator()(AccRef acc, const pg8::Unit& u, int wr, int wc, int fr, int fq, const LAS unsigned* st) const {
        const int row0 = u.pm * 256 + wr * 64 + fr;
        if (u.pn < 4) {
            ssq_t* ssd = (u.pn < 2) ? sscq : ssckv;
            const int col0 = u.pn * 256 + wc * 32 + 8 * fq;
#pragma unroll
            for (int ai = 0; ai < 2; ++ai)
#pragma unroll
                for (int m = 0; m < 4; ++m) { const int row = row0 + ai * 128 + m * 16; const float rs = rsqrtf(ssq_f(((ssq_t)st[256 + ai * 128 + wr * 64 + m * 16 + fr] << 32) | st[ai * 128 + wr * 64 + m * 16 + fr]) * (1.f / DM) + EPS); float s = 0.f;
#pragma unroll
                    for (int bj = 0; bj < 2; ++bj) { const f32x4 v0 = acc[ai][bj][m][0] * rs, v1 = acc[ai][bj][m][1] * rs; s += dot4(v0) + dot4(v1);
                        *(u32x4*)(cqkv + ((((size_t)(row >> 8) * 16 + ((col0 + bj * 128) >> 6)) * 256 + (row & 255)) * 64 + ((col0 + bj * 128) & 63))) = pack8v(v0, v1); }
                    s += __shfl_xor(s, 16); s += __shfl_xor(s, 32);
                    if (fq == 0) atomicAdd(ssd + row, ssq_fix(s)); }
        } else if (wc < 2) {
            const int cc = wc * 32 + 8 * fq, j0 = cc >> 1;
#pragma unroll
            for (int ai = 0; ai < 2; ++ai)
#pragma unroll
                for (int m = 0; m < 4; ++m) { const int row = row0 + ai * 128 + m * 16; const float rs = rsqrtf(ssq_f(((ssq_t)st[256 + ai * 128 + wr * 64 + m * 16 + fr] << 32) | st[ai * 128 + wr * 64 + m * 16 + fr]) * (1.f / DM) + EPS);
                    f32x4 v0 = acc[ai][0][m][0] * rs, v1 = acc[ai][0][m][1] * rs;
                    const f32x4 cs = *(const f32x4*)(rope + (size_t)row * 64 + j0), sn = *(const f32x4*)(rope + (size_t)row * 64 + 32 + j0);
                    rope8(v0, v1, cs, sn);
                    *(u32x4*)(kr + (size_t)row * 64 + cc) = pack8v(v0, v1); }
        }
    }
};
struct EpiUq {
    static constexpr bool PERM = true;
    const ssq_t* ss; bf16_t* q; const float* rope;
    static constexpr int NPRE = 8;
    __device__ __forceinline__ const ssq_t* stat() const { return ss; }
    __device__ __forceinline__ void operator()(AccRef acc, const pg8::Unit& u, int wr, int wc, int fr, int fq, const LAS unsigned* st) const {
        const int row0 = u.pm * 256 + wr * 64 + fr;
#pragma unroll
        for (int bj = 0; bj < 2; ++bj) {
            const int col = u.pn * 256 + bj * 128 + wc * 32 + 8 * fq; const int h = col / 192, wi = col - h * 192; const bool rot = wi >= 128; const int j0 = (wi - 128) >> 1;
#pragma unroll
            for (int ai = 0; ai < 2; ++ai)
#pragma unroll
                for (int m = 0; m < 4; ++m) { const int row = row0 + ai * 128 + m * 16; const float rs = rsqrtf(ssq_f(((ssq_t)st[256 + ai * 128 + wr * 64 + m * 16 + fr] << 32) | st[ai * 128 + wr * 64 + m * 16 + fr]) * (1.f / 512.f) + EPS);
                    f32x4 v0 = acc[ai][bj][m][0] * rs, v1 = acc[ai][bj][m][1] * rs;
                    if (rot) { const f32x4 cs = *(const f32x4*)(rope + (size_t)row * 64 + j0), sn = *(const f32x4*)(rope + (size_t)row * 64 + 32 + j0); rope8(v0, v1, cs, sn); }
                    *(u32x4*)(q + (size_t)row * NQ + col) = pack8v(v0, v1); }
        }
    }
};
template <int ACT> struct EpiScale {
    static constexpr bool PERM = true;
    const ssq_t* ss; float invk; bf16_t* o; int ldc;
    static constexpr int NPRE = 8;
    __device__ __forceinline__ const ssq_t* stat() const { return ss; }
    __device__ __forceinline__ void operator()(AccRef acc, const pg8::Unit& u, int wr, int wc, int fr, int fq, const LAS unsigned* st) const {
        const int row0 = u.pm * 256 + wr * 64 + fr, col0 = u.pn * 256 + wc * 32 + 8 * fq;
#pragma unroll
        for (int ai = 0; ai < 2; ++ai)
#pragma unroll
            for (int m = 0; m < 4; ++m) { const int row = row0 + ai * 128 + m * 16; const float rs = rsqrtf(ssq_f(((ssq_t)st[256 + ai * 128 + wr * 64 + m * 16 + fr] << 32) | st[ai * 128 + wr * 64 + m * 16 + fr]) * invk + EPS);
#pragma unroll
                for (int bj = 0; bj < 2; ++bj) { f32x4 v0 = acc[ai][bj][m][0] * rs, v1 = acc[ai][bj][m][1] * rs;
                    if (ACT == 1) {
                        const float INF = __builtin_inff();
#pragma unroll
                        for (int e = 0; e < 4; ++e) { v0[e] = __builtin_amdgcn_fmed3f(v0[e], 0.f, INF); v1[e] = __builtin_amdgcn_fmed3f(v1[e], 0.f, INF); }
                        v0 = v0 * v0; v1 = v1 * v1; }
                    if (ACT == 1) { const int cl = wc * 32 + 8 * fq + bj * 128;
                        *(u32x4*)(o + (((size_t)u.pm * (ldc >> 6) + u.pn * 4 + (cl >> 6)) * 256 + (row - u.pm * 256)) * 64 + (cl & 63)) = pack8v(v0, v1); }
                    else *(u32x4*)(o + (size_t)row * ldc + col0 + bj * 128) = pack8v(v0, v1); } }
    }
};
__device__ __forceinline__ f32x4 unpk_lo(u32x4 w) { f32x4 r; r[0] = __uint_as_float(w.x << 16); r[1] = __uint_as_float(w.x & 0xffff0000u); r[2] = __uint_as_float(w.y << 16); r[3] = __uint_as_float(w.y & 0xffff0000u); return r; }
__device__ __forceinline__ f32x4 unpk_hi(u32x4 w) { f32x4 r; r[0] = __uint_as_float(w.z << 16); r[1] = __uint_as_float(w.z & 0xffff0000u); r[2] = __uint_as_float(w.w << 16); r[3] = __uint_as_float(w.w & 0xffff0000u); return r; }
template <bool BF32, bool OF32> struct EpiRes2 {
    static constexpr bool PERM = true; static constexpr int NPRE = 0;
    const void* base; void* out; ssq_t* ss;
    __device__ __forceinline__ const ssq_t* stat() const { return nullptr; }
    __device__ __forceinline__ void operator()(AccRef acc, const pg8::Unit& u, int wr, int wc, int fr, int fq, const LAS unsigned*) const {
        const int row0 = u.pm * 256 + wr * 64 + fr, col0 = u.pn * 256 + wc * 32 + 8 * fq;
#pragma unroll
        for (int ai = 0; ai < 2; ++ai)
#pragma unroll
            for (int m = 0; m < 4; ++m) { const int row = row0 + ai * 128 + m * 16; float s = 0.f;
#pragma unroll
                for (int bj = 0; bj < 2; ++bj) { const size_t off = (BF32 || OF32) ? (size_t)row * DM + col0 + bj * 128 : xb_off(row, col0 + bj * 128); f32x4 b0, b1;
                    if (BF32) { b0 = *(const f32x4*)((const float*)base + off); b1 = *(const f32x4*)((const float*)base + off + 4); }
                    else { const u32x4 w = *(const u32x4*)((const bf16_t*)base + off); b0 = unpk_lo(w); b1 = unpk_hi(w); }
                    f32x4 o0 = b0 + acc[ai][bj][m][0], o1 = b1 + acc[ai][bj][m][1];
                    if (OF32) { *(f32x4*)((float*)out + off) = o0; *(f32x4*)((float*)out + off + 4) = o1; }
                    else { const u32x4 w = pack8v(o0, o1); *(u32x4*)((bf16_t*)out + off) = w; o0 = unpk_lo(w); o1 = unpk_hi(w); }
                    s += dot4(o0) + dot4(o1); }
                s += __shfl_xor(s, 16); s += __shfl_xor(s, 32);
                if (fq == 0) atomicAdd(ss + row, ssq_fix(s));
                asm volatile("" ::: "memory"); }
    }
};
namespace att {
constexpr int NW = 8, QBLK = 32, KVBLK = 64, QB = NW * QBLK;
constexpr int QS = NQ, KVS = NKV, KRS = 64, OS = DM;
constexpr int KROW = 384;
constexpr int SHM_V = KVBLK * 128 * 2, SHM_K = KVBLK * KROW;
constexpr int QR_OFF = 2 * SHM_V + 2 * SHM_K + NW * 64 * 4;
constexpr int LDS_BYTES = QR_OFF + NW * 4096;
constexpr float SCALE = 0.07216878364870322f;
constexpr float THR = 8.f;
constexpr int W = SEQ;
#define KSWZ(row, colB) ((row) * 384 + ((colB) ^ (((row) & 7) << 4)))
#define SBAR() __builtin_amdgcn_sched_barrier(0)
__device__ __forceinline__ int v_st(int k, int c) { const int kk = (k & ~0xC) | ((k & 4) << 1) | ((k & 8) >> 1); return ((kk >> 3) * 4 + (c >> 5)) * 512 + ((kk & 7) * 32 + (c & 31)) * 2; }
__device__ __forceinline__ int v_rd_base(int lane) { return ((lane & 3) << 3) | (((lane >> 2) & 3) << 6) | (((lane >> 4) & 1) << 5) | (((lane >> 5) & 1) << 8); }
constexpr int v_rd_off(int d0, int ks, int half) { return d0 * 512 + ks * 4096 + half * 2048; }
__device__ __forceinline__ int crow(int r, int hi) { return (r & 3) + 8 * (r >> 2) + 4 * hi; }
__device__ __forceinline__ bf16x8 load8(const bf16_t* p) { return *reinterpret_cast<const bf16x8*>(p); }
__device__ __forceinline__ void mask_tile(f32x16& p0, f32x16& p1, int dq, unsigned Wn) {
    const float NEG = -__builtin_inff();
#pragma unroll
    for (int r = 0; r < 16; ++r) {
        const int c = (r & 3) + 8 * (r >> 2);
        if ((unsigned)(dq - c) >= Wn) p0[r] = NEG;
        if ((unsigned)(dq - c - 32) >= Wn) p1[r] = NEG;
    }
}
__device__ __forceinline__ void partialSM(f32x16& p0, f32x16& p1, float& m_reg, float& mn, float& alpha) {
    float pmax = p0[0];
#pragma unroll
    for (int r = 1; r < 16; ++r) pmax = fmaxf(pmax, p0[r]);
#pragma unroll
    for (int r = 0; r < 16; ++r) pmax = fmaxf(pmax, p1[r]);
    { auto rr = __builtin_amdgcn_permlane32_swap(__float_as_uint(pmax), __float_as_uint(pmax), false, false);
      pmax = fmaxf(__uint_as_float(rr[0]), __uint_as_float(rr[1])); }
    constexpr float C2 = 1.4426950408889634f * SCALE;
    if (__builtin_expect(__all((pmax - m_reg) * SCALE <= THR), 1)) { mn = m_reg; alpha = 1.f; }
    else { mn = fmaxf(m_reg, pmax); alpha = __builtin_amdgcn_exp2f((m_reg - mn) * C2); m_reg = mn; }
    const float mnL = -mn * C2;
#pragma unroll
    for (int r = 0; r < 16; ++r) p0[r] = fmaf(p0[r], C2, mnL);
#pragma unroll
    for (int r = 0; r < 16; ++r) p1[r] = fmaf(p1[r], C2, mnL);
#pragma unroll
    for (int r = 0; r < 16; ++r) p0[r] = __builtin_amdgcn_exp2f(p0[r]);
}
__device__ __forceinline__ void finishSM(f32x16& p0, f32x16& p1, float alpha, float& l_reg, bf16x8& pa0, bf16x8& pa1, bf16x8& pa2, bf16x8& pa3) {
#pragma unroll
    for (int r = 0; r < 16; ++r) p1[r] = __builtin_amdgcn_exp2f(p1[r]);
    float ps = 0;
#pragma unroll
    for (int r = 0; r < 16; ++r) ps += p0[r];
#pragma unroll
    for (int r = 0; r < 16; ++r) ps += p1[r];
    { auto rr = __builtin_amdgcn_permlane32_swap(__float_as_uint(ps), __float_as_uint(ps), false, false);
      ps = __uint_as_float(rr[0]) + __uint_as_float(rr[1]); }
    l_reg = l_reg * alpha + ps;
#define PK4(P, B_, OUT) do { unsigned a0 = cvt_pk_bf16(P[B_+0], P[B_+1]), a1 = cvt_pk_bf16(P[B_+2], P[B_+3]);                          \
        unsigned b0 = cvt_pk_bf16(P[B_+4], P[B_+5]), b1 = cvt_pk_bf16(P[B_+6], P[B_+7]);                                             \
        auto r0 = __builtin_amdgcn_permlane32_swap(a0, b0, false, false); auto r1 = __builtin_amdgcn_permlane32_swap(a1, b1, false, false); \
        u32x4 w = {r0[0], r1[0], r0[1], r1[1]}; OUT = *reinterpret_cast<bf16x8*>(&w); } while (0)
    PK4(p0, 0, pa0); PK4(p0, 8, pa1); PK4(p1, 0, pa2); PK4(p1, 8, pa3);
#undef PK4
}
template <int KB>
__device__ __forceinline__ void qkt(f32x16& p0, f32x16& p1, const char* K_lds, int r32, int hi, const bf16x8* qr, const LAS char* qrp) {
    p0 = f32x16{}; p1 = f32x16{};
    asm volatile("" : "+v"(qrp));
    const char* kb[4];
#pragma unroll
    for (int dd = 0; dd < 4; ++dd) kb[dd] = K_lds + KB * SHM_K + KSWZ(r32, (dd * 16 + hi * 8) * 2);
#pragma unroll
    for (int d0 = 0; d0 < 12; ++d0) { const char* a = kb[d0 & 3] + (d0 >> 2) * 128;
        bf16x8 b0 = *reinterpret_cast<const bf16x8*>(a);
        bf16x8 b1 = *reinterpret_cast<const bf16x8*>(a + 32 * KROW);
        const bf16x8 qv = d0 < 8 ? qr[d0 & 7] : *reinterpret_cast<const LAS bf16x8*>(qrp + (d0 - 8) * 1024);
        p0 = __builtin_amdgcn_mfma_f32_32x32x16_bf16(b0, qv, p0, 0, 0, 0);
        p1 = __builtin_amdgcn_mfma_f32_32x32x16_bf16(b1, qv, p1, 0, 0, 0); }
}
template <int VB>
__device__ __forceinline__ void pv_tile(f32x16* o, int vb0, bf16x8 pa0, bf16x8 pa1, bf16x8 pa2, bf16x8 pa3) {
#define TRRD(dst, off) asm volatile("ds_read_b64_tr_b16 %0, %1 offset:%2" : "=&v"(dst) : "v"(vb0), "i"(off) : "memory")
#define PV_D0(d0) do { s16x4 l0, l1, l2, l3, h0, h1, h2, h3; constexpr int b_ = VB * SHM_V + v_rd_off(d0, 0, 0); \
        TRRD(l0, b_); TRRD(h0, b_ + 2048); TRRD(l1, b_ + 4096); TRRD(h1, b_ + 6144); TRRD(l2, b_ + 8192); TRRD(h2, b_ + 10240); TRRD(l3, b_ + 12288); TRRD(h3, b_ + 14336); \
        asm volatile("s_waitcnt lgkmcnt(0)" ::: "memory"); SBAR();   \
        o[d0] = __builtin_amdgcn_mfma_f32_32x32x16_bf16(pa0, (bf16x8){l0[0], l0[1], l0[2], l0[3], h0[0], h0[1], h0[2], h0[3]}, o[d0], 0, 0, 0);   \
        o[d0] = __builtin_amdgcn_mfma_f32_32x32x16_bf16(pa1, (bf16x8){l1[0], l1[1], l1[2], l1[3], h1[0], h1[1], h1[2], h1[3]}, o[d0], 0, 0, 0);   \
        o[d0] = __builtin_amdgcn_mfma_f32_32x32x16_bf16(pa2, (bf16x8){l2[0], l2[1], l2[2], l2[3], h2[0], h2[1], h2[2], h2[3]}, o[d0], 0, 0, 0);   \
        o[d0] = __builtin_amdgcn_mfma_f32_32x32x16_bf16(pa3, (bf16x8){l3[0], l3[1], l3[2], l3[3], h3[0], h3[1], h3[2], h3[3]}, o[d0], 0, 0, 0); } while (0)
    PV_D0(0); PV_D0(1); PV_D0(2); PV_D0(3);
#undef PV_D0
#undef TRRD
}

struct BlockRef { const bf16_t* Q; const bf16_t* K; const bf16_t* V; const bf16_t* R; bf16_t* O; int P0; };
struct Seam { bf16x8 qr[8]; bf16x8 st_0, st_1, st_r; };
#define VMW() asm volatile("s_waitcnt vmcnt(0)" ::: "memory")
#define VMWN(n) asm volatile("s_waitcnt vmcnt(%0)" :: "i"(n) : "memory")
#define SLOAD_K(B_, k0) do { const char* kb_ = (const char*)(B_).K + (size_t)(k0) * (KVS * 2); const char* kb2_ = kb_ + 32 * KVS * 2; const char* rb_ = (const char*)(B_).R + (size_t)(k0) * (KRS * 2);   \
                             S.st_0 = *(const bf16x8*)(kb_ + glo); S.st_1 = *(const bf16x8*)(kb2_ + glo); S.st_r = *(const bf16x8*)(rb_ + gro); } while (0)
#define SLOAD_V(B_, k0) do { const char* kb_ = (const char*)(B_).K + (size_t)(k0) * (KVS * 2); const char* kb2_ = kb_ + 32 * KVS * 2;   \
                             S.st_0 = *(const bf16x8*)(kb_ + 256 + glo); S.st_1 = *(const bf16x8*)(kb2_ + 256 + glo); } while (0)
#define SWRITE_K(bf) do { *(bf16x8*)(K_lds + (bf) * SHM_K + kws) = S.st_0; *(bf16x8*)(K_lds + (bf) * SHM_K + kws + 32 * KROW) = S.st_1; *(bf16x8*)(K_lds + (bf) * SHM_K + krs) = S.st_r; } while (0)
#define SWRITE_V(bf) do { *(bf16x8*)(V_lds + (bf) * SHM_V + vst0) = S.st_0; *(bf16x8*)(V_lds + (bf) * SHM_V + vst0 + 8192) = S.st_1; } while (0)
#define QLOAD(B_) do { const char* qb_ = (const char*)(B_).Q + (size_t)(wid * QBLK) * (QS * 2); const unsigned qo_ = (unsigned)(r32 * QS + hi * 8) * 2u; _Pragma("unroll") for (int d0 = 0; d0 < 8; ++d0) S.qr[d0] = *(const bf16x8*)(qb_ + d0 * 32 + qo_); } while (0)
#define QRLOAD(B_) do { bf16x8 qt_[4]; _Pragma("unroll") for (int d0 = 0; d0 < 4; ++d0) qt_[d0] = *(const bf16x8*)((const char*)(B_).Q + (size_t)(wid * QBLK) * (QS * 2) + 256 + d0 * 32 + (unsigned)(r32 * QS + hi * 8) * 2u); VMW(); \
                        _Pragma("unroll") for (int d0 = 0; d0 < 4; ++d0) *(LAS bf16x8*)(qrp + d0 * 1024) = qt_[d0]; asm volatile("s_waitcnt lgkmcnt(0)" ::: "memory"); } while (0)
#define QRP_DECL LAS char* qrp = (LAS char*)lds + QR_OFF + wid * 4096 + lane * 16

__device__ __forceinline__ void prime(const BlockRef& cur, char* lds, Seam& S) {
    const int tid = threadIdx.x, wid = __builtin_amdgcn_readfirstlane(tid >> 6), lane = tid & 63, r32 = lane & 31, hi = lane >> 5;
    const int sr = tid >> 4, sc = (tid & 15) * 8, kws = KSWZ(sr, sc * 2), rr = tid >> 3, rc = (tid & 7) * 8, krs = KSWZ(rr, 256 + rc * 2); char* K_lds = lds + 2 * SHM_V;
    const unsigned glo = (unsigned)(sr * KVS + sc) * 2u, gro = (unsigned)(rr * KRS + rc) * 2u;
    QRP_DECL;
    QLOAD(cur);
    SLOAD_K(cur, 0); VMW(); SWRITE_K(0); SBAR();
    QRLOAD(cur);
    SLOAD_V(cur, 0);
    __syncthreads();
}
__device__ __forceinline__ void block(const BlockRef& cur, const BlockRef& nxt, char* lds, Seam& S) {
    const int tid = threadIdx.x, wid = __builtin_amdgcn_readfirstlane(tid >> 6), lane = tid & 63, r32 = lane & 31, hi = lane >> 5;
    const int NT = (cur.P0 + QB - 1) / KVBLK + 1;
    const int qlo = cur.P0 + wid * QBLK, qm = qlo + r32 - 4 * hi;
    char* V_lds = lds; char* K_lds = lds + 2 * SHM_V;
    float* ws = (float*)(lds + 2 * SHM_V + 2 * SHM_K) + wid * 64; float* li_l = ws, * al_l = ws + 32;
    float m_reg = -1e30f, l_reg = 0; f32x16 o[4] = {};
    const int sr = tid >> 4, sc = (tid & 15) * 8, vst0 = v_st(sr, sc), kws = KSWZ(sr, sc * 2), rr = tid >> 3, rc = (tid & 7) * 8, krs = KSWZ(rr, 256 + rc * 2);
    const unsigned glo = (unsigned)(sr * KVS + sc) * 2u, gro = (unsigned)(rr * KRS + rc) * 2u;
    const int vb0 = (int)(uintptr_t)V_lds + v_rd_base(lane);
    QRP_DECL;
#define RESC(a) do { if (__any((a) < 1.f)) { if (hi == 0) al_l[r32] = (a); asm volatile("s_waitcnt lgkmcnt(0)" ::: "memory");              \
                     for (int d_ = 0; d_ < 4; ++d_) for (int r = 0; r < 16; ++r) o[d_][r] *= al_l[crow(r, hi)]; } } while (0)
#define KBASE(t) ((t) * KVBLK)
#define MASKT(P0_, P1_, t) do { const int kb_ = KBASE(t); if (kb_ + KVBLK - 1 > qlo) mask_tile(P0_, P1_, qm - kb_, (unsigned)W); } while (0)
    constexpr int NQL = 8;
#define SEAM_K0() do { VMWN(NQL); SWRITE_K(0); SBAR(); SLOAD_V(nxt, 0); SBAR(); } while (0)
    f32x16 pA0, pA1, pB0, pB1; float mnA, mnB, alA, alB; bf16x8 pa0, pa1, pa2, pa3;
    VMW(); SWRITE_V(0); SBAR();
    if (NT > 1) { SLOAD_K(cur, KBASE(1)); }
    SBAR(); qkt<0>(pA0, pA1, K_lds, r32, hi, S.qr, qrp);
    if (NT > 1) { VMW(); SWRITE_K(1); SBAR(); SLOAD_V(cur, KBASE(1)); }
    MASKT(pA0, pA1, 0); partialSM(pA0, pA1, m_reg, mnA, alA);
    if (NT > 1) { VMW(); SWRITE_V(1); SBAR(); if (NT > 2) SLOAD_K(cur, KBASE(2)); }
    __syncthreads();
#define HALF_STEP(PX0, PX1, mnX, alX, PY0, PY1, alY, t, KB, VB, SB) do {                                                      \
        SBAR(); qkt<KB>(PX0, PX1, K_lds, r32, hi, S.qr, qrp);                                                                      \
        finishSM(PY0, PY1, alY, l_reg, pa0, pa1, pa2, pa3); SBAR();                                                           \
        if ((t) + 1 < NT) { VMW(); SWRITE_K(SB); SBAR(); SLOAD_V(cur, KBASE((t) + 1)); SBAR(); }                              \
        pv_tile<VB>(o, vb0, pa0, pa1, pa2, pa3); MASKT(PX0, PX1, (t)); partialSM(PX0, PX1, m_reg, mnX, alX);                  \
        __syncthreads();                                                                                                      \
        if ((t) + 1 < NT) { VMW(); SWRITE_V(SB); SBAR(); if ((t) + 2 < NT) SLOAD_K(cur, KBASE((t) + 2)); }                    \
        RESC(alX); __syncthreads(); } while (0)
    for (int t = 1; t + 1 < NT; t += 2) {
        HALF_STEP(pB0, pB1, mnB, alB, pA0, pA1, alA, t, 1, 0, 0);
        HALF_STEP(pA0, pA1, mnA, alA, pB0, pB1, alB, t + 1, 0, 1, 1);
    }
    const bool even = (NT & 1) == 0;
    if (even) { SBAR(); qkt<1>(pB0, pB1, K_lds, r32, hi, S.qr, qrp); SBAR(); }
    SLOAD_K(nxt, 0); SBAR();
    QLOAD(nxt);
    SBAR();
    finishSM(pA0, pA1, alA, l_reg, pa0, pa1, pa2, pa3); SBAR();
    pv_tile<0>(o, vb0, pa0, pa1, pa2, pa3);
    if (even) { MASKT(pB0, pB1, NT - 1); partialSM(pB0, pB1, m_reg, mnB, alB); __syncthreads(); RESC(alB);
        finishSM(pB0, pB1, alB, l_reg, pa0, pa1, pa2, pa3); SBAR(); pv_tile<1>(o, vb0, pa0, pa1, pa2, pa3); }
    SBAR(); SEAM_K0();
    if (hi == 0) li_l[r32] = l_reg; asm volatile("s_waitcnt lgkmcnt(0)" ::: "memory");
    float rli[16];
#pragma unroll
    for (int r = 0; r < 16; ++r) rli[r] = __builtin_amdgcn_rcpf(li_l[crow(r, hi)]);
    bf16_t* Ow = cur.O + (size_t)(wid * QBLK) * 64;
#pragma unroll
    for (int r = 0; r < 16; ++r) { const int orow = crow(r, hi);
#pragma unroll
        for (int d0 = 0; d0 < 4; ++d0) { const float v = o[d0][r] * rli[r];
            const float vn = __shfl_xor(v, 1);
            if ((r32 & 1) == 0) *(unsigned*)(Ow + ((size_t)(d0 >> 1) * 256 + orow) * 64 + (d0 & 1) * 32 + r32) = cvt_pk_bf16(v, vn); } }
    QRLOAD(nxt);
    __syncthreads();
#undef RESC
#undef KBASE
#undef MASKT
#undef SEAM_K0
#undef HALF_STEP
}
#undef VMW
#undef VMWN
#undef SLOAD_K
#undef SLOAD_V
#undef SWRITE_K
#undef SWRITE_V
#undef QLOAD
#undef QRLOAD
#undef QRP_DECL

__device__ __forceinline__ void decode(int L, int& bh, int& x) { const int xcd = L & 7, k = (L >> 3) & 63, gi = k >> 3, r = k & 7; bh = gi * 8 + xcd; x = r; }
__device__ __forceinline__ BlockRef mkref(int bh, int qb, const bf16_t* Q, const bf16_t* KV, const bf16_t* KR, bf16_t* O) {
    const int b = bh >> 4, h = bh & 15; BlockRef r;
    r.Q = Q + ((size_t)b * SEQ + (size_t)qb * QB) * QS + h * 192; r.O = O + ((size_t)(b * (SEQ / QB) + qb) * (OS / 64) + 2 * h) * (256 * 64);
    r.K = KV + (size_t)b * SEQ * KVS + h * 256; r.V = r.K + 128; r.R = KR + (size_t)b * SEQ * KRS; r.P0 = qb * QB;
    return r;
}
__device__ __forceinline__ void attn_phase(char* lds, const bf16_t* Q, const bf16_t* KV, const bf16_t* KR, bf16_t* O) {
    constexpr int total = 512 * REP_ATT; const int stride = gridDim.x;
    int L = blockIdx.x; if (L >= total) return;
    int bh, x; decode(L, bh, x); int pass = 0;
    BlockRef cur = mkref(bh, x, Q, KV, KR, O);
    Seam S;
    prime(cur, lds, S);
    for (;;) {
        const bool more_pass = pass == 0, more_item = L + stride < total, last = !more_pass && !more_item;
        int bhn = bh, xn = x, passn = pass + 1, Ln = L;
        if (!more_pass) { passn = 0; Ln = more_item ? L + stride : L; decode(Ln, bhn, xn); }
        const BlockRef nxt = last ? cur : mkref(bhn, passn ? 15 - xn : xn, Q, KV, KR, O);
        block(cur, nxt, lds, S);
        if (last) break;
        cur = nxt; bh = bhn; x = xn; pass = passn; L = Ln;
    }
}
}

__device__ __forceinline__ float wave_sum(float v) {
#pragma unroll
    for (int o = 1; o < 64; o <<= 1) v += __shfl_xor(v, o);
    return v;
}
template <int MODE> __device__ __forceinline__ int srccol(int n) {
    if (MODE == 1) { const int h = n / 192, w = n - h * 192; if (w < 128) return n; const int i = w - 128; return h * 192 + 128 + (i & 1) * 32 + (i >> 1); }
    if (MODE == 2) { if (n < 1024) return n; if (n >= 1088) return -1; const int i = n - 1024; return 1024 + (i & 1) * 32 + (i >> 1); }
    return n;
}
template <int MODE>
__device__ __forceinline__ void p0_item(const float* W, int K, int Nsrc, bf16_t* WT, LAS float* scr, int item, int nblk, int lane, const float* ks, const float* ns) {
    const int kb = item / nblk, nb = item - kb * nblk, k0 = 64 * kb, n0 = 32 * nb;
    const int nn = n0 + (lane & 31), sc = srccol<MODE>(nn);
    const float nsv = ns ? ns[nn] : 1.f;
    const char* ub = (const char*)(W + (size_t)k0 * Nsrc);
    const unsigned vo = (unsigned)((lane >> 5) * Nsrc + (sc >= 0 ? sc : 0)) * 4u;
    const float* ksp = ks ? ks + k0 + (lane >> 5) : nullptr;
#pragma unroll 16
    for (int i = 0; i < 32; ++i) { float v = 0.f;
        if (sc >= 0) { v = *(const float*)(ub + (size_t)(2 * i) * Nsrc * 4 + vo) * nsv; if (ks) v *= ksp[2 * i]; }
        scr[(2 * i + (lane >> 5)) * 33 + (lane & 31)] = v; }
    asm volatile("s_waitcnt lgkmcnt(0)" ::: "memory");
    const int c = lane & 7;
#pragma unroll
    for (int j = 0; j < 4; ++j) { const int n = (lane >> 3) + 8 * j; const LAS float* s = scr + (8 * c) * 33 + n;
        u32x4 o; o.x = cvt_pk_bf16(s[0 * 33], s[1 * 33]); o.y = cvt_pk_bf16(s[2 * 33], s[3 * 33]); o.z = cvt_pk_bf16(s[4 * 33], s[5 * 33]); o.w = cvt_pk_bf16(s[6 * 33], s[7 * 33]);
        *(u32x4*)(WT + (size_t)(n0 + n) * K + k0 + 8 * c) = o; }
    asm volatile("s_waitcnt lgkmcnt(0)" ::: "memory");
}

struct Conv { const float* W; bf16_t* WT; const float* ks; const float* ns; int K, N, mode, nblk; int tiled = 0; };
__device__ __forceinline__ int dstrow(int mode, int c) {
    if (mode == 1) { const int h = c / 192, w = c - h * 192; if (w < 128) return c; const int is = w - 128; return h * 192 + 128 + 2 * (is & 31) + (is >> 5); }
    if (mode == 2) { if (c < 1024) return c; const int is = c - 1024; return 1024 + 2 * (is & 31) + (is >> 5); }
    return c;
}
__device__ __forceinline__ void conv_task(const Conv& d, int task, int lane) {
    const int kb = task / d.nblk, nb = task - kb * d.nblk, k0 = kb * 16, n = nb * 256 + lane * 4;
    if (n >= d.N) return;
    const char* ub = (const char*)(d.W + (size_t)k0 * d.N); const unsigned vo = (unsigned)n * 4u;
    f32x4 v[16];
#pragma unroll
    for (int r = 0; r < 16; ++r) v[r] = *(const f32x4*)(ub + (size_t)r * d.N * 4 + vo);
    if (d.ks) {
#pragma unroll
        for (int r = 0; r < 16; ++r) v[r] = v[r] * d.ks[k0 + r]; }
    if (d.ns) { const f32x4 nv = *(const f32x4*)(d.ns + n);
#pragma unroll
        for (int r = 0; r < 16; ++r) v[r] = v[r] * nv; }
#pragma unroll
    for (int j = 0; j < 4; ++j) { const int dr = dstrow(d.mode, n + j);
        bf16_t* o = d.tiled ? d.WT + (((size_t)(dr >> 8) * (d.K >> 6) + (k0 >> 6)) * 256 + (dr & 255)) * 64 + (k0 & 63) : d.WT + (size_t)dr * d.K + k0;
        u32x4 w0, w1; w0.x = cvt_pk_bf16(v[0][j], v[1][j]); w0.y = cvt_pk_bf16(v[2][j], v[3][j]); w0.z = cvt_pk_bf16(v[4][j], v[5][j]); w0.w = cvt_pk_bf16(v[6][j], v[7][j]);
        w1.x = cvt_pk_bf16(v[8][j], v[9][j]); w1.y = cvt_pk_bf16(v[10][j], v[11][j]); w1.z = cvt_pk_bf16(v[12][j], v[13][j]); w1.w = cvt_pk_bf16(v[14][j], v[15][j]);
        *(u32x4*)o = w0; *(u32x4*)(o + 8) = w1; }
}

#define XB_TMO      128
#define XB_XCNT(j)  (256  + 64 * (j))
#define XB_XSUB(j)  (1280 + 64 * (j))
#define XB_XGEN(j)  (2304 + 64 * (j))
#define XB_TOP      3328
#define XB_TOPGEN   3392
#define XCD_BAR_WORDS 3456
#define XB_SPIN_CAP (1u << 18)

__device__ __forceinline__ unsigned xb_ld(unsigned* p)              { return __hip_atomic_load(p, __ATOMIC_RELAXED, __HIP_MEMORY_SCOPE_AGENT); }
__device__ __forceinline__ unsigned xb_add(unsigned* p, unsigned v) { return __hip_atomic_fetch_add(p, v, __ATOMIC_RELAXED, __HIP_MEMORY_SCOPE_AGENT); }
__device__ __forceinline__ unsigned xb_xcc_id() { return (unsigned)__builtin_amdgcn_s_getreg((3 << 11) | 20) & 0xFu; }
#define XB_SPIN(cond, bar) do { unsigned _sp = 0; while (cond) { __builtin_amdgcn_s_sleep(1); \
    if ((++_sp & 255u) == 0u) { if (xb_ld(&(bar)[XB_TMO])) break; if (_sp > XB_SPIN_CAP) { atomicAdd(&(bar)[XB_TMO], 1u); break; } } } } while (0)

struct XcdBarrier {
    unsigned* bar; unsigned x;
    volatile LAS unsigned* st;
};

__device__ __forceinline__ XcdBarrier xcd_barrier_post(unsigned* bar, volatile LAS unsigned* st) {
    XcdBarrier b; b.bar = bar; b.x = xb_xcc_id(); b.st = st;
    if (threadIdx.x == 0) (void)xb_add(&bar[XB_XCNT(b.x)], 1u);
    return b;
}
__device__ __forceinline__ void xcd_barrier_complete(unsigned* bar, unsigned x, unsigned& nloc, unsigned& nx) {
    const unsigned G = gridDim.x * gridDim.y * gridDim.z;
    unsigned sum, cnt, mine, sp = 0u;
    for (;;) {
        sum = 0u; cnt = 0u; mine = 0u;
#pragma unroll
        for (unsigned j = 0; j < 16; ++j) { const unsigned c = xb_ld(&bar[XB_XCNT(j)]); sum += c; cnt += (c > 0u) ? 1u : 0u; mine = (j == x) ? c : mine; }
        if (sum == G) break;
        __builtin_amdgcn_s_sleep(1);
        if ((++sp & 255u) == 0u) { if (xb_ld(&bar[XB_TMO])) break; if (sp > XB_SPIN_CAP) { atomicAdd(&bar[XB_TMO], 1u); break; } }
    }
    nloc = mine > 0u ? mine : 1u; nx = cnt > 0u ? cnt : 1u;
}

__device__ __forceinline__ void xcd_barrier(const XcdBarrier& b) {
    asm volatile("s_waitcnt vmcnt(0)" ::: "memory");
    __syncthreads();
    if (threadIdx.x == 0) {
        unsigned* bar = b.bar;
        __builtin_amdgcn_s_waitcnt(0);
        unsigned nloc = b.st[0], nx = b.st[1];
        if (nloc == 0u) { xcd_barrier_complete(bar, b.x, nloc, nx); b.st[0] = nloc; b.st[1] = nx; }
        const unsigned old = xb_add(&bar[XB_XSUB(b.x)], 1u);
        const unsigned gen = old / nloc;
        if (old + 1u == (gen + 1u) * nloc) {
            __builtin_amdgcn_fence(__ATOMIC_RELEASE, "agent");
            asm volatile("s_waitcnt vmcnt(0)" ::: "memory");
            const unsigned og = xb_add(&bar[XB_TOP], 1u);
            const unsigned tg = og / nx;
            if (og + 1u == (tg + 1u) * nx) xb_add(&bar[XB_TOPGEN], 1u);
            else XB_SPIN(xb_ld(&bar[XB_TOPGEN]) == tg, bar);
            __builtin_amdgcn_fence(__ATOMIC_ACQUIRE, "agent");
            xb_add(&bar[XB_XGEN(b.x)], 1u);
            asm volatile("s_waitcnt vmcnt(0)" ::: "memory");
        } else {
            XB_SPIN(xb_ld(&bar[XB_XGEN(b.x)]) == gen, bar);
            __builtin_amdgcn_fence(__ATOMIC_ACQUIRE, "agent");
            asm volatile("s_waitcnt vmcnt(0)" ::: "memory");
        }
    }
    __syncthreads();
}

__device__ __forceinline__ f32x4 ldh4(const bf16_t* p) { const u32x2 w = *(const u32x2*)p; f32x4 r; r[0] = __uint_as_float(w.x << 16); r[1] = __uint_as_float(w.x & 0xffff0000u); r[2] = __uint_as_float(w.y << 16); r[3] = __uint_as_float(w.y & 0xffff0000u); return r; }
struct Params {
    const float* x; const int* pos; const float* ln_mix; const float* ln_mlp; const float* w_dqkv; const float* q_norm; const float* kv_norm;
    const float* w_uq; const float* w_ukv; const float* w_o; const float* w_pool; const float* pool_scale; const float* w_up; const float* w_down; const float* final_norm;
    float* out; unsigned char* ws;
};

#ifndef REP_P0
#define REP_P0 1
#endif
#ifndef REP_ATT
#define REP_ATT 1
#endif
#ifndef REP_UP
#define REP_UP 1
#endif
constexpr int LDS_TOTAL = STAT_LDS_OFF + 4096;
static_assert(att::LDS_BYTES <= 131072, "attention LDS");

__global__ void __launch_bounds__(512, 2) mega_fwd(Params p) {
    extern __shared__ __attribute__((aligned(16))) unsigned char lds[];
    cg::grid_group grid = cg::this_grid();
    LAS unsigned char* ldsl = (LAS unsigned char*)lds;
    const int tid = threadIdx.x, lane = tid & 63, wave = __builtin_amdgcn_readfirstlane(tid >> 6);
    const int G = gridDim.x, bid = blockIdx.x;
    const int gw = bid * 8 + wave, NGW = G * 8;
    unsigned char* ws = p.ws;
    ssq_t* ctl = (ssq_t*)(ws + WS_CTL);
    bf16_t* Wdqkv = (bf16_t*)(ws + WS_WDQKV); bf16_t* Wuq = (bf16_t*)(ws + WS_WUQ); bf16_t* Wukv = (bf16_t*)(ws + WS_WUKV); bf16_t* Wo = (bf16_t*)(ws + WS_WO);
    bf16_t* Wpool = (bf16_t*)(ws + WS_WPOOL); bf16_t* Wup0 = (bf16_t*)(ws + WS_WUP0); bf16_t* Wdn0 = (bf16_t*)(ws + WS_WDN0);
    bf16_t* Wup1 = (bf16_t*)p.out; bf16_t* Wdn1 = (bf16_t*)p.out + (size_t)DM * FF;
    float* rope = (float*)(ws + WS_ROPE);
    bf16_t* XB = (bf16_t*)(ws + WS_XB); bf16_t* Qb = (bf16_t*)(ws + WS_Q); bf16_t* KVb = (bf16_t*)(ws + WS_KV); bf16_t* CQKV = (bf16_t*)(ws + WS_CQKV);
    bf16_t* Ob = (bf16_t*)(ws + WS_O); bf16_t* KRb = (bf16_t*)(ws + WS_KR); bf16_t* Hb = (bf16_t*)(ws + WS_H); bf16_t* Yb = (bf16_t*)(ws + WS_Y);
    LAS float* scr = (LAS float*)(ldsl + wave * 16384);
    volatile LAS unsigned* misc = (volatile LAS unsigned*)(ldsl + 131072 + 512);
    if (tid < 8) misc[tid] = 0u;
    __syncthreads();
    XcdBarrier xbar = xcd_barrier_post((unsigned*)(ws + WS_BAR), misc);

    for (int rep_ = 0; rep_ < REP_P0; ++rep_) {
        for (int i = bid * 512 + tid; i < SS_END - T; i += G * 512) ctl[T + i] = 0ull;
        for (int i = bid * 512 + tid; i < T * 32; i += G * 512) {
            const int t = i >> 5, j = i & 31; const float inv = 1.0f / powf(10000.0f, (float)(2 * j) * (1.0f / 64.0f));
            const float ang = (float)p.pos[t] * inv; float sn, cs; sincosf(ang, &sn, &cs);
            rope[(size_t)t * 64 + j] = cs; rope[(size_t)t * 64 + 32 + j] = sn;
        }
        for (int m = gw; m < T; m += NGW) {
            const f32x4* xr = (const f32x4*)(p.x + (size_t)m * DM) + lane; float s = 0.f;
            f32x4 xv[8];
#pragma unroll
            for (int j = 0; j < 8; ++j) xv[j] = xr[64 * j];
            asm volatile("" ::: "memory");
#pragma unroll
            for (int j = 0; j < 8; ++j) { const f32x4 v = xv[j]; s += dot4(v); u32x2 w; w.x = cvt_pk_bf16(v[0], v[1]); w.y = cvt_pk_bf16(v[2], v[3]); *(u32x2*)(XB + xb_off(m, 256 * j + 4 * lane)) = w; }
            s = wave_sum(s); if (lane == 0) ctl[SS_X + m] = ssq_fix(s);
        }
        for (int i = bid * 512 + tid; i < (DM / 64) * 1536; i += G * 512) { const int kt = i / 1536, r = i - kt * 1536;
            ((u32x4*)(Wdqkv + (((size_t)4 * (DM / 64) + kt) * 256 + 64) * 64))[r] = (u32x4){0u, 0u, 0u, 0u}; }
        for (int it = gw; it < (DM / 16) * 5; it += NGW) { const Conv d{p.w_dqkv, Wdqkv, p.ln_mix, nullptr, DM, 1088, 2, 5, 1}; conv_task(d, it, lane); }
    }
    if (p.ws == nullptr) grid.sync();
    xcd_barrier(xbar);
    {
        const int NG1 = (G * 5) / 8;
        if (bid < NG1) {
            pg8::Gemm g{XB, Wdqkv, DM, DM, DM, 0, 1, 1}; pg8::StaticOrder S; S.init(T, NDQ, NG1, bid);
            EpiDqkv E{ctl + SS_X, ctl + SS_CQ, ctl + SS_CKV, CQKV, KRb, rope};
            pg8::gemm_phase(ldsl, g, S, E);
        }
        {
            constexpr int T_UQ = (512 / 16) * (NQ / 256), T_UKV = (512 / 16) * (NKV / 256), T_O = (DM / 16) * (DM / 256), T_PL = (512 / 16) * 2;
            constexpr int T_UP = (DM / 16) * (FF / 256), T_DN = (FF / 16) * (DM / 256);
            constexpr int NTASK = T_UQ + T_UKV + T_O + 4 * T_PL + 2 * T_UP + 2 * T_DN;
            unsigned* qctr = (unsigned*)(ws + WS_BAR) + 3800;
            for (;;) {
                unsigned it0 = 0u; if (lane == 0) it0 = __hip_atomic_fetch_add(qctr, 2u, __ATOMIC_RELAXED, __HIP_MEMORY_SCOPE_AGENT);
                const int itb = __builtin_amdgcn_readfirstlane((int)it0);
                if (itb >= NTASK) break;
                for (int it = itb; it < itb + 2 && it < NTASK; ++it) {
                    int r = it; Conv d;
                    if (r < T_UQ) d = Conv{p.w_uq, Wuq, p.q_norm, nullptr, 512, NQ, 1, NQ / 256, 1};
                    else if ((r -= T_UQ) < T_UKV) d = Conv{p.w_ukv, Wukv, p.kv_norm, nullptr, 512, NKV, 0, NKV / 256, 1};
                    else if ((r -= T_UKV) < T_O) d = Conv{p.w_o, Wo, nullptr, nullptr, DM, DM, 0, DM / 256, 1};
                    else if ((r -= T_O) < 4 * T_PL) { const int g = r / T_PL; r -= g * T_PL; d = Conv{p.w_pool + (size_t)g * 512 * 512, Wpool + (size_t)g * 512 * 512, nullptr, p.pool_scale + g * 512, 512, 512, 0, 2, 1}; }
                    else if ((r -= 4 * T_PL) < T_UP) d = Conv{p.w_up, Wup0, p.ln_mlp, nullptr, DM, FF, 0, FF / 256, 1};
                    else if ((r -= T_UP) < T_DN) d = Conv{p.w_down, Wdn0, nullptr, nullptr, FF, DM, 0, DM / 256, 1};
                    else if ((r -= T_DN) < T_UP) d = Conv{p.w_up + (size_t)DM * FF, Wup1, p.ln_mlp + DM, nullptr, DM, FF, 0, FF / 256, 1};
                    else { r -= T_UP; d = Conv{p.w_down + (size_t)FF * DM, Wdn1, nullptr, nullptr, FF, DM, 0, DM / 256, 1}; }
                    conv_task(d, r, lane);
                }
            }
        }
    }
    xcd_barrier(xbar);
    {
        pg8::Gemm g{CQKV, Wuq, 1024, 512, 512, 0, 1, 1, 16}; pg8::StaticOrder S; S.init(T, NQ, G, bid);
        EpiUq E{ctl + SS_CQ, Qb, rope};
        pg8::gemm_phase(ldsl, g, S, E);
    }
    {
        pg8::Gemm g{CQKV + 8 * 256 * 64, Wukv, 1024, 512, 512, 0, 1, 1, 16}; pg8::StaticOrder S; S.init(T, NKV, G, bid);
        EpiScale<0> E{ctl + SS_CKV, 1.f / 512.f, KVb, NKV};
        pg8::gemm_phase(ldsl, g, S, E);
    }
    xcd_barrier(xbar);
    if (__builtin_amdgcn_readfirstlane((int)threadIdx.x) >= 256) __builtin_amdgcn_s_setprio(1);
    att::attn_phase((char*)lds, Qb, KVb, KRb, Ob);
    __builtin_amdgcn_s_setprio(0);
    xcd_barrier(xbar);
    {
        pg8::Gemm g{Ob, Wo, DM, DM, DM, 0, 1, 1}; pg8::StaticOrder S; S.init(T, DM, G, bid);
        EpiRes2<false, false> E{XB, XB, ctl + SS_H1};
        pg8::gemm_phase(ldsl, g, S, E);
    }
    xcd_barrier(xbar);
    for (int rep_ = 0; rep_ < REP_UP; ++rep_) {
        pg8::Gemm g{XB, Wup0, DM, DM, DM, 0, 1, 1}; pg8::StaticOrder S; S.init(T, FF, G, bid);
        EpiScale<1> E{ctl + SS_H1, 1.f / DM, Hb, FF};
        pg8::gemm_phase(ldsl, g, S, E);
    }
    xcd_barrier(xbar);
    {
        pg8::Gemm g{Hb, Wdn0, FF, FF, FF, 0, 1, 1}; pg8::StaticOrder S; S.init(T, DM, G, bid);
        EpiRes2<false, false> E{XB, XB, ctl + SS_H2};
        pg8::gemm_phase(ldsl, g, S, E);
    }
    xcd_barrier(xbar);
    {
        for (int it = gw; it < (T / 32) * 8; it += NGW) {
            const int tch = it >> 3, cs = it & 7, c = cs * 256 + lane * 4, w = 2 << (cs >> 1);
            const int t0 = tch * 32, s0 = t0 & (SEQ - 1);
            const f32x4 gv = *(const f32x4*)(p.ln_mix + DM + c);
            const bf16_t* hp = XB; const ssq_t* ssr = ctl + SS_H2;
            f32x4 run = {0.f, 0.f, 0.f, 0.f};
            for (int j = 1; j < w; ++j) if (s0 - j >= 0) { const int t = t0 - j; const float rs = rsqrtf(ssq_f(ssr[t]) * (1.f / DM) + EPS); run += ldh4(hp + xb_off(t, c)) * gv * rs; }
            for (int i0 = 0; i0 < 32; i0 += 8) {
                f32x4 cur[8], old[8];
#pragma unroll
                for (int k = 0; k < 8; ++k) { const int t = t0 + i0 + k; cur[k] = ldh4(hp + xb_off(t, c));
                    const int so = s0 + i0 + k - (w - 1); const int to = so >= 0 ? t - (w - 1) : t; old[k] = ldh4(hp + xb_off(to, c)); }
                asm volatile("" ::: "memory");
#pragma unroll
                for (int k = 0; k < 8; ++k) { const int i = i0 + k, t = t0 + i; const float rs = rsqrtf(ssq_f(ssr[t]) * (1.f / DM) + EPS);
                    const f32x4 v = cur[k] * gv * rs; run += v;
                    const int cn = (s0 + i + 1) < w ? (s0 + i + 1) : w; const f32x4 y = run * (1.f / (float)cn) - v;
                    u32x2 o; o.x = cvt_pk_bf16(y[0], y[1]); o.y = cvt_pk_bf16(y[2], y[3]); *(u32x2*)(Yb + xb_off(t, c)) = o;
                    const int so = s0 + i - (w - 1);
                    if (so >= 0) { const int to = t - (w - 1); const float ro = rsqrtf(ssq_f(ssr[to]) * (1.f / DM) + EPS); run -= old[k] * gv * ro; } }
            }
        }
    }
    xcd_barrier(xbar);
    {
        pg8::Gemm g{Yb, Wpool, DM, 512, 512, 1, 1, 1, 32}; pg8::StaticOrder S; S.init(T, DM, G, bid);
        EpiRes2<false, false> E{XB, XB, ctl + SS_H3};
        pg8::gemm_phase(ldsl, g, S, E);
    }
    xcd_barrier(xbar);
    {
        pg8::Gemm g{XB, Wup1, DM, DM, DM, 0, 1, 1}; pg8::StaticOrder S; S.init(T, FF, G, bid);
        EpiScale<1> E{ctl + SS_H3, 1.f / DM, Hb, FF};
        pg8::gemm_phase(ldsl, g, S, E);
    }
    xcd_barrier(xbar);
    {
        pg8::Gemm g{Hb, Wdn1, FF, FF, FF, 0, 1, 1}; pg8::StaticOrder S; S.init(T, DM, G, bid);
        EpiRes2<false, false> E{XB, XB, ctl + SS_H4};
        pg8::gemm_phase(ldsl, g, S, E);
    }
    xcd_barrier(xbar);
    {
        f32x4 gn[8];
#pragma unroll
        for (int j = 0; j < 4; ++j) { gn[2 * j] = ((const f32x4*)p.final_norm)[2 * lane + 128 * j]; gn[2 * j + 1] = ((const f32x4*)p.final_norm)[2 * lane + 128 * j + 1]; }
        for (int m = gw; m < T; m += NGW) {
            const float rs = rsqrtf(ssq_f(ctl[SS_H4 + m]) * (1.f / DM) + EPS);
            f32x4* orow = (f32x4*)(p.out + (size_t)m * DM) + 2 * lane;
            u32x4 hw[4];
#pragma unroll
            for (int j = 0; j < 4; ++j) hw[j] = *(const u32x4*)(XB + xb_off(m, 512 * j + 8 * lane));
            asm volatile("" ::: "memory");
#pragma unroll
            for (int j = 0; j < 4; ++j) { orow[128 * j] = unpk_lo(hw[j]) * gn[2 * j] * rs; orow[128 * j + 1] = unpk_hi(hw[j]) * gn[2 * j + 1] * rs; }
        }
    }
}

extern "C" void kernel_launch(void* const* d_in, const int* in_sizes, int n_in, void* d_out, int out_size, void* d_ws, size_t ws_size, hipStream_t stream) {
    static int grid_blocks = 0;
    if (grid_blocks == 0) {
        if (n_in != 15 || in_sizes[0] != T * DM || out_size != T * DM || ws_size < WS_END) {
            fprintf(stderr, "kernel_launch: unexpected shapes (n_in %d, in0 %d, out %d, ws %zu)\n", n_in, n_in > 0 ? in_sizes[0] : -1, out_size, ws_size); grid_blocks = -1; return; }
        int dev = 0, cus = 0, per_cu = 0;
        (void)hipGetDevice(&dev); (void)hipDeviceGetAttribute(&cus, hipDeviceAttributeMultiprocessorCount, dev);
        if (hipFuncSetAttribute((const void*)mega_fwd, hipFuncAttributeMaxDynamicSharedMemorySize, LDS_TOTAL) != hipSuccess) fprintf(stderr, "kernel_launch: hipFuncSetAttribute failed\n");
        if (hipOccupancyMaxActiveBlocksPerMultiprocessor(&per_cu, (const void*)mega_fwd, 512, LDS_TOTAL) != hipSuccess || per_cu < 1) per_cu = 1;
        (void)hipGetLastError();
        if (cus <= 0) cus = 256;
        grid_blocks = cus * per_cu;
    }
    if (grid_blocks < 0) return;
    if (hipMemsetAsync((char*)d_ws + WS_BAR, 0, BAR_BYTES, stream) != hipSuccess) { fprintf(stderr, "kernel_launch: hipMemsetAsync failed\n"); return; }
    Params p{};
    p.x = (const float*)d_in[0]; p.pos = (const int*)d_in[1]; p.ln_mix = (const float*)d_in[2]; p.ln_mlp = (const float*)d_in[3]; p.w_dqkv = (const float*)d_in[4];
    p.q_norm = (const float*)d_in[5]; p.kv_norm = (const float*)d_in[6]; p.w_uq = (const float*)d_in[7]; p.w_ukv = (const float*)d_in[8]; p.w_o = (const float*)d_in[9];
    p.w_pool = (const float*)d_in[10]; p.pool_scale = (const float*)d_in[11]; p.w_up = (const float*)d_in[12]; p.w_down = (const float*)d_in[13]; p.final_norm = (const float*)d_in[14];
    p.out = (float*)d_out; p.ws = (unsigned char*)d_ws;
    void* args[] = {&p};
    hipError_t e = hipLaunchCooperativeKernel((const void*)mega_fwd, dim3(grid_blocks), dim3(512), args, LDS_TOTAL, stream);
    if (e != hipSuccess) fprintf(stderr, "kernel_launch: cooperative launch failed: %s (grid %d)\n", hipGetErrorString(e), grid_blocks);
}
```
